# Optimizing an MI355X kernel written in HIP

```python
import jax, jax.numpy as jnp
from jax import lax
import numpy as np

D_MODEL = 2048
BATCH = 4
SEQ = 4096
DEPTH = 2

N_SELF = DEPTH // 2
N_CROSS = DEPTH - N_SELF
CONV_WIDTH = 3
HEAD_DIM = 64
N_HEADS = D_MODEL // HEAD_DIM
N_KV_HEADS = max(1, N_HEADS // 8)
GROUP = N_HEADS // N_KV_HEADS
WINDOW = 128
BLOCK = 128
ROT_DIM = HEAD_DIM // 4
ROPE_THETA = 500000.0
D_FF = 4 * D_MODEL
EPS = 1e-6

kernel_name = "yoco_shortconv_swa_sink_hybrid"


def rms_norm(x, g):
    xf = x.astype(jnp.float32)
    y = xf * lax.rsqrt(jnp.mean(xf * xf, axis=-1, keepdims=True) + EPS)
    return (y * g.astype(jnp.float32)).astype(x.dtype)


def ada_mod(c_act, w, b, n):
    m = c_act @ w + b
    return jnp.split(m[:, None, :], n, axis=-1)


def rope_tables(seq):
    inv = ROPE_THETA ** (-jnp.arange(0, ROT_DIM, 2, dtype=jnp.float32) / ROT_DIM)
    ang = jnp.arange(seq, dtype=jnp.float32)[:, None] * inv[None, :]
    return jnp.cos(ang), jnp.sin(ang)


def partial_rope(t, cos, sin):
    half = ROT_DIM // 2
    cos = cos[None, :, None, :].astype(t.dtype)
    sin = sin[None, :, None, :].astype(t.dtype)
    t1 = t[..., :half]
    t2 = t[..., half:ROT_DIM]
    return jnp.concatenate([t1 * cos - t2 * sin, t2 * cos + t1 * sin, t[..., ROT_DIM:]], axis=-1)


def short_conv_mixer(h, w_in, w_conv, w_out):
    b_gate, c_gate, u = jnp.split(h @ w_in, 3, axis=-1)
    z = c_gate * u
    z = lax.conv_general_dilated(
        z, w_conv[:, None, :].astype(z.dtype),
        window_strides=(1,), padding=[(CONV_WIDTH - 1, 0)],
        dimension_numbers=('NWC', 'WIO', 'NWC'), feature_group_count=D_MODEL)
    return (b_gate * z) @ w_out


def squared_relu_mlp(h, w_up, w_down):
    a = jax.nn.relu(h @ w_up)
    return (a * a) @ w_down


def shared_kv(h_res, c_act, kv_ada_w, kv_ada_b, kv_norm, w_kv, b_kv, cos, sin):
    shift, scale = ada_mod(c_act, kv_ada_w, kv_ada_b, 2)
    h = rms_norm(h_res, kv_norm) * (1 + scale) + shift
    b, s, _ = h.shape
    kv = (h @ w_kv + b_kv).reshape(b, s, 2, N_KV_HEADS, HEAD_DIM)
    k = partial_rope(kv[:, :, 0], cos, sin)
    v = kv[:, :, 1]
    return k, v


def band_blocks(t):
    b, s, nh, d = t.shape
    nb = s // BLOCK
    prev = jnp.pad(t, ((0, 0), (BLOCK, 0), (0, 0), (0, 0)))[:, :s]
    return jnp.concatenate([prev.reshape(b, nb, BLOCK, nh, d),
                            t.reshape(b, nb, BLOCK, nh, d)], axis=2)


def sliding_window_sink_attention(h, k, v, w_q, b_q, sinks, w_o, b_o, cos, sin):
    b, s, _ = h.shape
    nb = s // BLOCK
    q = partial_rope((h @ w_q + b_q).reshape(b, s, N_HEADS, HEAD_DIM), cos, sin)
    qb = q.reshape(b, nb, BLOCK, N_KV_HEADS, GROUP, HEAD_DIM)
    kb = band_blocks(k)
    vb = band_blocks(v)
    scores = jnp.einsum('bnqkgd,bnskd->bnkgqs', qb, kb).astype(jnp.float32) * (HEAD_DIM ** -0.5)
    blk = jnp.arange(nb)[:, None, None]
    q_pos = blk * BLOCK + jnp.arange(BLOCK)[None, :, None]
    k_pos = (blk - 1) * BLOCK + jnp.arange(2 * BLOCK)[None, None, :]
    valid = (k_pos <= q_pos) & (k_pos > q_pos - WINDOW) & (k_pos >= 0)
    scores = jnp.where(valid[None, :, None, None], scores, -jnp.inf)
    sink = jnp.broadcast_to(
        sinks.astype(jnp.float32).reshape(N_KV_HEADS, GROUP)[None, None, :, :, None, None],
        scores.shape[:-1] + (1,))
    probs = jax.nn.softmax(jnp.concatenate([scores, sink], axis=-1), axis=-1)[..., :-1]
    o = jnp.einsum('bnkgqs,bnskd->bnqkgd', probs.astype(vb.dtype), vb)
    return o.reshape(b, s, N_HEADS * HEAD_DIM) @ w_o + b_o


def setup_inputs(seed: int = 0) -> dict:
    key = jax.random.key(seed)
    ks = jax.random.split(key, 21)
    D = D_MODEL
    nrm = jax.random.normal
    kv_dim = 2 * N_KV_HEADS * HEAD_DIM
    q_dim = N_HEADS * HEAD_DIM
    return {
        "x": nrm(ks[0], (BATCH, SEQ, D), jnp.float32),
        "c": nrm(ks[1], (BATCH, D), jnp.float32),
        "ada_w": nrm(ks[2], (DEPTH, 2, D, 3 * D), jnp.float32) * (0.5 * D ** -0.5),
        "ada_b": nrm(ks[3], (DEPTH, 2, 3 * D), jnp.float32) * 0.02,
        "norm_pre": 1.0 + 0.1 * nrm(ks[4], (DEPTH, 2, D), jnp.float32),
        "norm_post": 1.0 + 0.1 * nrm(ks[5], (DEPTH, 2, D), jnp.float32),
        "conv_w_in": nrm(ks[6], (N_SELF, D, 3 * D), jnp.float32) * D ** -0.5,
        "conv_w": nrm(ks[7], (N_SELF, CONV_WIDTH, D), jnp.float32) * CONV_WIDTH ** -0.5,
        "conv_w_out": nrm(ks[8], (N_SELF, D, D), jnp.float32) * D ** -0.5,
        "kv_ada_w": nrm(ks[9], (D, 2 * D), jnp.float32) * (0.5 * D ** -0.5),
        "kv_ada_b": nrm(ks[10], (2 * D,), jnp.float32) * 0.02,
        "kv_norm": 1.0 + 0.1 * nrm(ks[11], (D,), jnp.float32),
        "w_kv": nrm(ks[12], (D, kv_dim), jnp.float32) * D ** -0.5,
        "b_kv": nrm(ks[13], (kv_dim,), jnp.float32) * 0.02,
        "w_q": nrm(ks[14], (N_CROSS, D, q_dim), jnp.float32) * D ** -0.5,
        "b_q": nrm(ks[15], (N_CROSS, q_dim), jnp.float32) * 0.02,
        "sinks": nrm(ks[16], (N_CROSS, N_HEADS), jnp.float32),
        "w_o": nrm(ks[17], (N_CROSS, q_dim, D), jnp.float32) * q_dim ** -0.5,
        "b_o": nrm(ks[18], (N_CROSS, D), jnp.float32) * 0.02,
        "mlp_up": nrm(ks[19], (DEPTH, D, D_FF), jnp.float32) * D ** -0.5,
        "mlp_down": nrm(ks[20], (DEPTH, D_FF, D), jnp.float32) * D_FF ** -0.5,
    }


def reference(x, c, ada_w, ada_b, norm_pre, norm_post, conv_w_in, conv_w, conv_w_out,
              kv_ada_w, kv_ada_b, kv_norm, w_kv, b_kv, w_q, b_q, sinks, w_o, b_o,
              mlp_up, mlp_down):
    cos, sin = rope_tables(x.shape[1])
    c_act = jax.nn.silu(c)
    k = v = None
    for l in range(DEPTH):
        shift, scale, gate = ada_mod(c_act, ada_w[l, 0], ada_b[l, 0], 3)
        h = rms_norm(x, norm_pre[l, 0]) * (1 + scale) + shift
        if l < N_SELF:
            y = short_conv_mixer(h, conv_w_in[l], conv_w[l], conv_w_out[l])
        else:
            if l == N_SELF:
                k, v = shared_kv(x, c_act, kv_ada_w, kv_ada_b, kv_norm, w_kv, b_kv, cos, sin)
            a = l - N_SELF
            y = sliding_window_sink_attention(h, k, v, w_q[a], b_q[a], sinks[a],
                                              w_o[a], b_o[a], cos, sin)
        x = x + gate * rms_norm(y, norm_post[l, 0])
        shift, scale, gate = ada_mod(c_act, ada_w[l, 1], ada_b[l, 1], 3)
        h = rms_norm(x, norm_pre[l, 1]) * (1 + scale) + shift
        x = x + gate * rms_norm(squared_relu_mlp(h, mlp_up[l], mlp_down[l]), norm_post[l, 1])
    return x
```

```cpp
#include <hip/hip_runtime.h>
#include <hip/hip_cooperative_groups.h>
#include <cstdio>
#include <cstdint>
#include <cmath>
namespace cg = cooperative_groups;

#ifndef MK_N_LAUNCHES
#define MK_N_LAUNCHES 1
#endif
#ifndef MK_XCD_BAR
#define MK_XCD_BAR 0
#endif

#define LAS __attribute__((address_space(3)))
typedef unsigned short bf16_t;
typedef short bf16x8 __attribute__((ext_vector_type(8)));
typedef short s16x4 __attribute__((ext_vector_type(4)));
typedef float f32x4 __attribute__((ext_vector_type(4)));
typedef float f32x16 __attribute__((ext_vector_type(16)));
typedef unsigned u32x4 __attribute__((ext_vector_type(4)));
typedef unsigned u32x2 __attribute__((ext_vector_type(2)));
typedef float f32x2_t __attribute__((ext_vector_type(2)));
typedef __bf16 bf16x2_t __attribute__((ext_vector_type(2)));

constexpr int DM = 2048, NBATCH = 4, SEQ = 4096, T = NBATCH * SEQ, DFF = 8192, NH = 32, NKV = 4, HD = 64;
constexpr int NTOT = 4 * 6144 + 4096;
constexpr int KC = 8;
constexpr float EPS = 1e-6f;
constexpr float LOG2E = 1.4426950408889634f;
constexpr float QSCALE = 0.125f * LOG2E;

constexpr size_t MiB = 1u << 20;
constexpr size_t WS_CTL = 0, CTL_ZERO_BYTES = 64 * 1024;
constexpr size_t WS_MODP = 1 * MiB;
constexpr size_t WS_ROPE = 5 * MiB;
constexpr size_t WS_WIN = 8 * MiB, WS_WOUT = 32 * MiB, WS_WUP0 = 40 * MiB, WS_WUP1 = 72 * MiB, WS_WDN0 = 104 * MiB, WS_WDN1 = 136 * MiB;
constexpr size_t WS_WQ = 168 * MiB, WS_WKV = 176 * MiB, WS_WO = 178 * MiB;
constexpr size_t WS_H = 192 * MiB;
constexpr size_t WS_ZQ = 256 * MiB;
constexpr size_t WS_BO = 320 * MiB;
constexpr size_t WS_GK = 384 * MiB;
constexpr size_t WS_A = 448 * MiB;
constexpr size_t WS_K = 704 * MiB;
constexpr size_t WS_VT = 712 * MiB;
constexpr size_t WS_END = 720 * MiB;

constexpr int LDS_BYTES = 147456;
constexpr int NWAVES = 8;

__device__ __forceinline__ unsigned cvtpk(float lo, float hi) { f32x2_t v = {lo, hi}; bf16x2_t b = __builtin_convertvector(v, bf16x2_t); return __builtin_bit_cast(unsigned, b); }
__device__ __forceinline__ float bf_lo(unsigned u) { return __uint_as_float(u << 16); }
__device__ __forceinline__ float bf_hi(unsigned u) { return __uint_as_float(u & 0xffff0000u); }
__device__ __forceinline__ void st8(bf16_t* p, f32x4 v0, f32x4 v1) { u32x4 w; w.x = cvtpk(v0[0], v0[1]); w.y = cvtpk(v0[2], v0[3]); w.z = cvtpk(v1[0], v1[1]); w.w = cvtpk(v1[2], v1[3]); *(u32x4*)p = w; }

namespace pg8 {
#define PG8_LAS __attribute__((address_space(3)))
constexpr int BM = 256, BK = 64, HALF = 128, HTB = HALF * BK * 2, STAGE_BYTES = 8 * HTB, NXCD = 8, WGM = 8;
__host__ __device__ __forceinline__ int lds_byte(int r, int c) { const int st = (r >> 4) * 2 + (c >> 5), rr = r & 15, cc = c & 31, ob = rr * 64 + cc * 2; return st * 1024 + (ob ^ (((ob >> 9) & 1) << 5)); }
__host__ __device__ __forceinline__ void stage_rc(int b, int& R, int& C) { const int st = b / 1024, sb = b % 1024, swz = sb ^ (((sb >> 9) & 1) << 5); R = (st >> 1) * 16 + swz / 64; C = (st & 1) * 32 + (swz % 64) / 2; }
__host__ __device__ __forceinline__ int perm32(int rho) { const int n = rho >> 4, i = rho & 15; return 8 * (i >> 2) + 4 * n + (i & 3); }

struct Unit { int pm, pn; };
struct Gemm { const bf16_t* A; const bf16_t* Bt; int M, N, K; };
struct StaticOrder {
    int nM, nN, nwg, G, c;
    __host__ __device__ void init(int M, int N, int G_, int c_) { nM = M / BM; nN = N / BM; nwg = nM * nN; G = G_; c = c_; }
    __host__ __device__ bool next(int i, Unit& u) const {
        const long L = (long)i * G + c; if (L >= nwg) return false;
        int wgid = (int)L; { const int q = nwg / NXCD, r = nwg % NXCD, xcd = wgid % NXCD, off = wgid / NXCD; wgid = (xcd < r ? xcd * (q + 1) : r * (q + 1) + (xcd - r) * q) + off; }
        const int nig = WGM * nN, gid = wgid / nig, fm = gid * WGM, gsz = (nM - fm) < WGM ? (nM - fm) : WGM;
        u.pm = fm + ((wgid % nig) % gsz); u.pn = (wgid % nig) / gsz; return true;
    }
};


template <int ACT> struct EpiBf16 {
    bf16_t* O; int ldc; const float* bias;
    __device__ __forceinline__ void operator()(const f32x4 (&acc)[2][2][4][2], const Unit& u, int wr, int wc, int fr, int fq) const {
        const int row0 = u.pm * BM + wr * 64 + fr, col0 = u.pn * BM + wc * 32 + 8 * fq;
        f32x4 bv[2][2];
#pragma unroll
        for (int bj = 0; bj < 2; ++bj)
#pragma unroll
            for (int n = 0; n < 2; ++n) bv[bj][n] = bias ? *(const f32x4*)(bias + col0 + bj * HALF + 4 * n) : (f32x4){0.f, 0.f, 0.f, 0.f};
#pragma unroll
        for (int ai = 0; ai < 2; ++ai)
#pragma unroll
            for (int m = 0; m < 4; ++m) { bf16_t* rowp = O + (size_t)(row0 + ai * HALF + m * 16) * ldc + col0;
#pragma unroll
                for (int bj = 0; bj < 2; ++bj) { f32x4 v0 = acc[ai][bj][m][0] + bv[bj][0], v1 = acc[ai][bj][m][1] + bv[bj][1];
                    if (ACT == 1) { v0 = __builtin_elementwise_max(v0, (f32x4){0.f, 0.f, 0.f, 0.f}); v1 = __builtin_elementwise_max(v1, (f32x4){0.f, 0.f, 0.f, 0.f}); v0 = v0 * v0; v1 = v1 * v1; }
                    st8(rowp + bj * HALF, v0, v1); } }
    }
};
struct EpiZB {
    bf16_t* Z; bf16_t* Bg;
    __device__ __forceinline__ void operator()(const f32x4 (&acc)[2][2][4][2], const Unit& u, int wr, int wc, int fr, int fq) const {
        const int row0 = u.pm * BM + wr * 64 + fr;
        if (u.pn < 16) {
            const int col0 = u.pn * HALF + wc * 32 + 8 * fq;
#pragma unroll
            for (int ai = 0; ai < 2; ++ai)
#pragma unroll
                for (int m = 0; m < 4; ++m) st8(Z + (size_t)(row0 + ai * HALF + m * 16) * DM + col0, acc[ai][0][m][0] * acc[ai][1][m][0], acc[ai][0][m][1] * acc[ai][1][m][1]);
        } else {
            const int col0 = (u.pn - 16) * BM + wc * 32 + 8 * fq;
#pragma unroll
            for (int ai = 0; ai < 2; ++ai)
#pragma unroll
                for (int m = 0; m < 4; ++m)
#pragma unroll
                    for (int bj = 0; bj < 2; ++bj) st8(Bg + (size_t)(row0 + ai * HALF + m * 16) * DM + col0 + bj * HALF, acc[ai][bj][m][0], acc[ai][bj][m][1]);
        }
    }
};
__device__ __forceinline__ void rope8(f32x4& v0, f32x4& v1, const float* rope, int pos, int fq) {
    f32x4 p0, p1;
#pragma unroll
    for (int e = 0; e < 4; ++e) { p0[e] = __shfl_xor(v0[e], 16); p1[e] = __shfl_xor(v1[e], 16); }
    if (fq < 2) {
        const float* rp = rope + (size_t)pos * 16;
        const f32x4 c0 = *(const f32x4*)(rp), c1 = *(const f32x4*)(rp + 4), s0 = *(const f32x4*)(rp + 8), s1 = *(const f32x4*)(rp + 12);
        if (fq == 0) { v0 = v0 * c0 - p0 * s0; v1 = v1 * c1 - p1 * s1; }
        else         { v0 = v0 * c0 + p0 * s0; v1 = v1 * c1 + p1 * s1; }
    }
}
struct EpiQ {
    bf16_t* O; const float* bias; const float* rope;
    __device__ __forceinline__ void operator()(const f32x4 (&acc)[2][2][4][2], const Unit& u, int wr, int wc, int fr, int fq) const {
        const int row0 = u.pm * BM + wr * 64 + fr, col0 = u.pn * BM + wc * 32 + 8 * fq;
#pragma unroll
        for (int ai = 0; ai < 2; ++ai)
#pragma unroll
            for (int m = 0; m < 4; ++m) { const int row = row0 + ai * HALF + m * 16;
#pragma unroll
                for (int bj = 0; bj < 2; ++bj) {
                    f32x4 v0 = acc[ai][bj][m][0] + *(const f32x4*)(bias + col0 + bj * HALF), v1 = acc[ai][bj][m][1] + *(const f32x4*)(bias + col0 + bj * HALF + 4);
                    if ((wc & 1) == 0) rope8(v0, v1, rope, row & (SEQ - 1), fq);
                    st8(O + (size_t)row * DM + col0 + bj * HALF, v0 * QSCALE, v1 * QSCALE); } }
    }
};
struct EpiKV {
    bf16_t* Kb; bf16_t* Vt; const float* bias; const float* rope;
    __device__ __forceinline__ void operator()(const f32x4 (&acc)[2][2][4][2], const Unit& u, int wr, int wc, int fr, int fq) const {
        const int row0 = u.pm * BM + wr * 64 + fr, colt = wc * 32 + 8 * fq;
#pragma unroll
        for (int ai = 0; ai < 2; ++ai)
#pragma unroll
            for (int m = 0; m < 4; ++m) { const int row = row0 + ai * HALF + m * 16, pos = row & (SEQ - 1), b = row / SEQ;
#pragma unroll
                for (int bj = 0; bj < 2; ++bj) { const int col = colt + bj * HALF;
                    f32x4 v0 = acc[ai][bj][m][0] + *(const f32x4*)(bias + u.pn * BM + col), v1 = acc[ai][bj][m][1] + *(const f32x4*)(bias + u.pn * BM + col + 4);
                    if (u.pn == 0) { if ((wc & 1) == 0) rope8(v0, v1, rope, pos, fq); st8(Kb + (size_t)row * 256 + col, v0, v1); }
                    else { const int kvh = col >> 6, d = col & 63; bf16_t* vp = Vt + ((size_t)(b * NKV + kvh) * HD + d) * SEQ + pos;
#pragma unroll
                        for (int e = 0; e < 4; ++e) { vp[(size_t)e * SEQ] = (bf16_t)(cvtpk(v0[e], 0.f) & 0xffffu); vp[(size_t)(e + 4) * SEQ] = (bf16_t)(cvtpk(v1[e], 0.f) & 0xffffu); } } } }
    }
};

template <class Epi, class Sched, bool ALIGN_EPI = false, bool SP2 = false>
__device__ __forceinline__ void gemm_phase(PG8_LAS unsigned char* lds, const Gemm g, const Sched& S, const Epi& E) {
    const int tid = threadIdx.x, wid = __builtin_amdgcn_readfirstlane(tid >> 6), lane = tid & 63, wr = wid >> 2, wc = wid & 3, fr = lane & 15, fq = lane >> 4;
    const int K = g.K, nt = K / BK;
    unsigned voffA[2], voffB[2];
#pragma unroll
    for (int i = 0; i < 2; ++i) { int R, C; stage_rc(tid * 16 + i * 8192, R, C); const int Rb = (R & ~31) + perm32(R & 31);
        voffA[i] = (unsigned)(R * K + C) * 2u; voffB[i] = (unsigned)(Rb * K + C) * 2u; }
    const size_t kstep = (size_t)(BK * 2);
    const size_t hstep = (size_t)HALF * K * 2;
    const size_t tstep = 2 * hstep;
    const unsigned ldsw = (unsigned)wid * 1024u;
    const int aoff = lds_byte(wr * 64 + fr, fq * 8), boff = lds_byte(wc * 32 + fr, fq * 8);
#define PG8_SA(b, h) (((b) * 2 + (h)) * HTB)
#define PG8_SB(b, h) ((4 + (b) * 2 + (h)) * HTB)
#define PG8_STAGE(bufoff, gbase, voff) do { _Pragma("unroll") for (int _i = 0; _i < 2; ++_i) \
        __builtin_amdgcn_global_load_lds((const unsigned*)((const char*)(gbase) + (voff)[_i]), (PG8_LAS unsigned*)(lds + (bufoff) + ldsw + _i * 8192), 16, 0, 0); } while (0)
#define PG8_LDA(dst, b, h) do { _Pragma("unroll") for (int m = 0; m < 4; ++m) _Pragma("unroll") for (int k = 0; k < 2; ++k) dst[m][k] = *(const PG8_LAS bf16x8*)(lds + PG8_SA(b, h) + aoff + m * 2048 + k * 1024); } while (0)
#define PG8_LDB(dst, b, h) do { _Pragma("unroll") for (int n = 0; n < 2; ++n) _Pragma("unroll") for (int k = 0; k < 2; ++k) dst[n][k] = *(const PG8_LAS bf16x8*)(lds + PG8_SB(b, h) + boff + n * 2048 + k * 1024); } while (0)
#define PG8_MMA(ai, bj, At, Bt) do { __builtin_amdgcn_s_setprio(1); _Pragma("unroll") for (int m = 0; m < 4; ++m) _Pragma("unroll") for (int n = 0; n < 2; ++n) _Pragma("unroll") for (int k = 0; k < 2; ++k) \
        acc[ai][bj][m][n] = __builtin_amdgcn_mfma_f32_16x16x32_bf16(Bt[n][k], At[m][k], acc[ai][bj][m][n], 0, 0, 0); __builtin_amdgcn_s_setprio(0); } while (0)
#define PG8_WAIT_V(n) asm volatile("s_waitcnt vmcnt(" #n ")" ::: "memory")
#define PG8_WAIT_L(n) asm volatile("s_waitcnt lgkmcnt(" #n ")" ::: "memory")
#define PG8_BAR __builtin_amdgcn_s_barrier()
#define PG8_SCHED __builtin_amdgcn_sched_barrier(0)
    Unit cur, nxt; int ui = 0;
    if (!S.next(0, cur)) return;
    f32x4 acc[2][2][4][2];
#pragma unroll
    for (int a = 0; a < 2; ++a)
#pragma unroll
        for (int b = 0; b < 2; ++b)
#pragma unroll
            for (int m = 0; m < 4; ++m)
#pragma unroll
                for (int n = 0; n < 2; ++n) acc[a][b][m][n] = (f32x4){0.f, 0.f, 0.f, 0.f};
    bf16x8 At[4][2], B0[2][2], B1[2][2];
    const char* cA = (const char*)g.A + (size_t)cur.pm * tstep; const char* cB = (const char*)g.Bt + (size_t)cur.pn * tstep;
    if constexpr (SP2) {
        PG8_STAGE(PG8_SB(0, 0), cB, voffB); PG8_STAGE(PG8_SB(0, 1), cB + hstep, voffB); PG8_STAGE(PG8_SA(0, 0), cA, voffA); PG8_STAGE(PG8_SA(0, 1), cA + hstep, voffA);
        if (wr == 1) PG8_BAR;
        PG8_WAIT_V(2); PG8_BAR;
        PG8_STAGE(PG8_SB(1, 0), cB + kstep, voffB); PG8_STAGE(PG8_SA(1, 0), cA + kstep, voffA); PG8_STAGE(PG8_SB(1, 1), cB + hstep + kstep, voffB);
        PG8_WAIT_V(6); PG8_BAR;
    } else {
        PG8_STAGE(PG8_SB(0, 0), cB, voffB); PG8_STAGE(PG8_SA(0, 0), cA, voffA); PG8_STAGE(PG8_SB(0, 1), cB + hstep, voffB); PG8_STAGE(PG8_SA(0, 1), cA + hstep, voffA);
        if (wr == 1) PG8_BAR;
        PG8_WAIT_V(4); PG8_BAR;
        PG8_STAGE(PG8_SB(1, 0), cB + kstep, voffB); PG8_STAGE(PG8_SA(1, 0), cA + kstep, voffA); PG8_STAGE(PG8_SB(1, 1), cB + hstep + kstep, voffB);
        PG8_WAIT_V(6); PG8_BAR;
    }
    for (;;) {
        const bool has_next = S.next(ui + 1, nxt);
        const char* nA = has_next ? (const char*)g.A + (size_t)nxt.pm * tstep : cA; const char* nB = has_next ? (const char*)g.Bt + (size_t)nxt.pn * tstep : cB;
        for (int t = 0; t < nt; t += 2) {
            const bool last = (t == nt - 2);
            const char* a1 = cA + (size_t)(t + 1) * kstep;
            const char* a2 = last ? nA : cA + (size_t)(t + 2) * kstep; const char* b2 = last ? nB : cB + (size_t)(t + 2) * kstep;
            const char* a3 = a2 + kstep; const char* b3 = b2 + kstep;
            if constexpr (SP2) {
            PG8_LDB(B0, 0, 0); PG8_LDB(B1, 0, 1); PG8_SCHED; PG8_LDA(At, 0, 0); PG8_STAGE(PG8_SA(1, 1), a1 + hstep, voffA);
            PG8_WAIT_V(8); PG8_WAIT_L(0); PG8_BAR; PG8_MMA(0, 0, At, B0); PG8_MMA(0, 1, At, B1); PG8_BAR; PG8_SCHED;
            PG8_LDA(At, 0, 1); PG8_STAGE(PG8_SB(0, 0), b2, voffB); PG8_STAGE(PG8_SB(0, 1), b2 + hstep, voffB); PG8_STAGE(PG8_SA(0, 0), a2, voffA);
            PG8_WAIT_V(8); PG8_WAIT_L(0); PG8_BAR; PG8_MMA(1, 0, At, B0); PG8_MMA(1, 1, At, B1); PG8_BAR; PG8_SCHED;
            PG8_LDB(B0, 1, 0); PG8_LDB(B1, 1, 1); PG8_SCHED; PG8_LDA(At, 1, 0); PG8_STAGE(PG8_SA(0, 1), a2 + hstep, voffA);
            PG8_WAIT_V(8); PG8_WAIT_L(0); PG8_BAR; PG8_MMA(0, 0, At, B0); PG8_MMA(0, 1, At, B1); PG8_BAR; PG8_SCHED;
            PG8_LDA(At, 1, 1); PG8_STAGE(PG8_SB(1, 0), b3, voffB); PG8_STAGE(PG8_SB(1, 1), b3 + hstep, voffB); PG8_STAGE(PG8_SA(1, 0), a3, voffA);
            PG8_WAIT_V(8); PG8_WAIT_L(0); PG8_BAR; PG8_MMA(1, 0, At, B0); PG8_MMA(1, 1, At, B1); PG8_BAR; PG8_SCHED;
            } else {
            PG8_LDB(B0, 0, 0); PG8_SCHED; PG8_LDA(At, 0, 0); PG8_STAGE(PG8_SA(1, 1), a1 + hstep, voffA);
            PG8_WAIT_L(8); PG8_BAR; PG8_WAIT_L(0); PG8_MMA(0, 0, At, B0); PG8_BAR; PG8_SCHED;
            PG8_LDB(B1, 0, 1); PG8_STAGE(PG8_SB(0, 0), b2, voffB);
            PG8_BAR; PG8_WAIT_L(0); PG8_MMA(0, 1, At, B1); PG8_BAR;
            PG8_LDA(At, 0, 1); PG8_STAGE(PG8_SA(0, 0), a2, voffA);
            PG8_BAR; PG8_WAIT_L(0); PG8_MMA(1, 0, At, B0); PG8_BAR; PG8_SCHED;
            PG8_STAGE(PG8_SB(0, 1), b2 + hstep, voffB);
            PG8_WAIT_V(6); PG8_BAR; PG8_MMA(1, 1, At, B1); PG8_BAR;
            PG8_LDB(B0, 1, 0); PG8_SCHED; PG8_LDA(At, 1, 0); PG8_STAGE(PG8_SA(0, 1), a2 + hstep, voffA);
            PG8_WAIT_L(8); PG8_BAR; PG8_WAIT_L(0); PG8_MMA(0, 0, At, B0); PG8_BAR; PG8_SCHED;
            PG8_LDB(B1, 1, 1); PG8_STAGE(PG8_SB(1, 0), b3, voffB);
            PG8_BAR; PG8_WAIT_L(0); PG8_MMA(0, 1, At, B1); PG8_BAR;
            PG8_LDA(At, 1, 1); PG8_STAGE(PG8_SA(1, 0), a3, voffA);
            PG8_BAR; PG8_WAIT_L(0); PG8_MMA(1, 0, At, B0); PG8_BAR; PG8_SCHED;
            PG8_STAGE(PG8_SB(1, 1), b3 + hstep, voffB);
            PG8_WAIT_V(6); PG8_BAR; PG8_MMA(1, 1, At, B1); PG8_BAR;
            }
        }
        if constexpr (ALIGN_EPI) { if (wr == 0) PG8_BAR; }
        E(acc, cur, wr, wc, fr, fq);
        if (!has_next) break;
#pragma unroll
        for (int a = 0; a < 2; ++a)
#pragma unroll
            for (int b = 0; b < 2; ++b)
#pragma unroll
                for (int m = 0; m < 4; ++m)
#pragma unroll
                    for (int n = 0; n < 2; ++n) acc[a][b][m][n] = (f32x4){0.f, 0.f, 0.f, 0.f};
        cur = nxt; cA = nA; cB = nB; ++ui;
        if constexpr (ALIGN_EPI) { if (wr == 1) PG8_BAR; }
    }
    PG8_WAIT_V(0);
    if constexpr (!ALIGN_EPI) { if (wr == 0) PG8_BAR; }
    PG8_BAR;
#undef PG8_SA
#undef PG8_SB
#undef PG8_STAGE
#undef PG8_LDA
#undef PG8_LDB
#undef PG8_MMA
#undef PG8_WAIT_V
#undef PG8_WAIT_L
#undef PG8_BAR
#undef PG8_SCHED
}
}

#define XB_TMO      128
#define XB_XCNT(j)  (256  + 64 * (j))
#define XB_XSUB(j)  (1280 + 64 * (j))
#define XB_XGEN(j)  (2304 + 64 * (j))
#define XB_TOP      3328
#define XB_TOPGEN   3392
#define XCD_BAR_WORDS 3456
#define XB_SPIN_CAP (1u << 22)
__device__ __forceinline__ unsigned xb_ld(unsigned* p)              { return __hip_atomic_load(p, __ATOMIC_RELAXED, __HIP_MEMORY_SCOPE_AGENT); }
__device__ __forceinline__ unsigned xb_add(unsigned* p, unsigned v) { return __hip_atomic_fetch_add(p, v, __ATOMIC_RELAXED, __HIP_MEMORY_SCOPE_AGENT); }
__device__ __forceinline__ unsigned xb_xcc_id() { return (unsigned)__builtin_amdgcn_s_getreg((3 << 11) | 20) & 0xFu; }
#define XB_SPIN(cond, bar) do { unsigned _sp = 0; while (cond) { __builtin_amdgcn_s_sleep(1); \
    if ((++_sp & 255u) == 0u) { if (xb_ld(&(bar)[XB_TMO])) break; if (_sp > XB_SPIN_CAP) { atomicAdd(&(bar)[XB_TMO], 1u); break; } } } } while (0)
struct XcdBarrier { unsigned* bar; unsigned x; volatile LAS unsigned* st; };
__device__ __forceinline__ XcdBarrier xcd_barrier_post(unsigned* bar, volatile LAS unsigned* st) {
    XcdBarrier b; b.bar = bar; b.x = xb_xcc_id(); b.st = st;
    if (threadIdx.x == 0) (void)xb_add(&bar[XB_XCNT(b.x)], 1u);
    return b;
}
__device__ __forceinline__ void xcd_barrier_complete(unsigned* bar, unsigned x, unsigned& nloc, unsigned& nx) {
    const unsigned G = gridDim.x * gridDim.y * gridDim.z;
    unsigned sum, cnt, mine, sp = 0u;
    for (;;) {
        sum = 0u; cnt = 0u; mine = 0u;
#pragma unroll
        for (unsigned j = 0; j < 16; ++j) { const unsigned c = xb_ld(&bar[XB_XCNT(j)]); sum += c; cnt += (c > 0u) ? 1u : 0u; mine = (j == x) ? c : mine; }
        if (sum == G) break;
        __builtin_amdgcn_s_sleep(1);
        if ((++sp & 255u) == 0u) { if (xb_ld(&bar[XB_TMO])) break; if (sp > XB_SPIN_CAP) { atomicAdd(&bar[XB_TMO], 1u); break; } }
    }
    nloc = mine > 0u ? mine : 1u; nx = cnt > 0u ? cnt : 1u;
}
__device__ __forceinline__ void xcd_barrier(const XcdBarrier& b) {
    asm volatile("s_waitcnt vmcnt(0)" ::: "memory");
    __syncthreads();
    if (threadIdx.x == 0) {
        unsigned* bar = b.bar;
        __builtin_amdgcn_s_waitcnt(0);
        unsigned nloc = b.st[0], nx = b.st[1];
        if (nloc == 0u) { xcd_barrier_complete(bar, b.x, nloc, nx); b.st[0] = nloc; b.st[1] = nx; }
        const unsigned old = xb_add(&bar[XB_XSUB(b.x)], 1u);
        const unsigned gen = old / nloc;
        if (old + 1u == (gen + 1u) * nloc) {
            __builtin_amdgcn_fence(__ATOMIC_RELEASE, "agent");
            asm volatile("s_waitcnt vmcnt(0)" ::: "memory");
            const unsigned og = xb_add(&bar[XB_TOP], 1u);
            const unsigned tg = og / nx;
            if (og + 1u == (tg + 1u) * nx) xb_add(&bar[XB_TOPGEN], 1u);
            else XB_SPIN(xb_ld(&bar[XB_TOPGEN]) == tg, bar);
            __builtin_amdgcn_fence(__ATOMIC_ACQUIRE, "agent");
            xb_add(&bar[XB_XGEN(b.x)], 1u);
            asm volatile("s_waitcnt vmcnt(0)" ::: "memory");
        } else {
            XB_SPIN(xb_ld(&bar[XB_XGEN(b.x)]) == gen, bar);
            __builtin_amdgcn_fence(__ATOMIC_ACQUIRE, "agent");
            asm volatile("s_waitcnt vmcnt(0)" ::: "memory");
        }
    }
    __syncthreads();
}

struct Args { const float* in[21]; float* out; unsigned char* ws; int ph_lo, ph_hi; };
enum { I_X = 0, I_C, I_ADAW, I_ADAB, I_NPRE, I_NPOST, I_CWIN, I_CONVW, I_CWOUT, I_KVADAW, I_KVADAB, I_KVNORM, I_WKV, I_BKV, I_WQ, I_BQ, I_SINKS, I_WO, I_BO, I_UP, I_DOWN };

__device__ __forceinline__ float wave_sum(float v) {
#pragma unroll
    for (int o = 1; o < 64; o <<= 1) v += __shfl_xor(v, o);
    return v;
}

__device__ __forceinline__ void transpose_item(const float* W, int K, int N, bf16_t* WT, int item, int mode, LAS float* scr, int lane) {
    const int nblk = N / 32, kb = item / nblk, nb = item % nblk, k0 = 64 * kb, n0 = 32 * nb;
    const int n4 = (lane & 7) * 4;
#pragma unroll
    for (int i = 0; i < 8; ++i) { const int kk = i * 8 + (lane >> 3); const f32x4 v = *(const f32x4*)(W + (size_t)(k0 + kk) * N + n0 + n4);
        scr[kk * 33 + n4 + 0] = v[0]; scr[kk * 33 + n4 + 1] = v[1]; scr[kk * 33 + n4 + 2] = v[2]; scr[kk * 33 + n4 + 3] = v[3]; }
    asm volatile("s_waitcnt lgkmcnt(0)" ::: "memory");
    int drow0 = n0;
    if (mode == 1) { const int grp = n0 / DM, ch = n0 % DM; drow0 = (grp == 0) ? (4096 + ch) : ((ch >> 7) * 256 + (grp == 2 ? 128 : 0) + (ch & 127)); }
    const int c = lane & 7;
#pragma unroll
    for (int j = 0; j < 4; ++j) { const int n = (lane >> 3) + 8 * j; const LAS float* s = scr + (8 * c) * 33 + n;
        u32x4 o; o.x = cvtpk(s[0 * 33], s[1 * 33]); o.y = cvtpk(s[2 * 33], s[3 * 33]); o.z = cvtpk(s[4 * 33], s[5 * 33]); o.w = cvtpk(s[6 * 33], s[7 * 33]);
        *(u32x4*)(WT + (size_t)(drow0 + n) * K + k0 + 8 * c) = o; }
    asm volatile("s_waitcnt lgkmcnt(0)" ::: "memory");
}

__device__ __forceinline__ void gemv_item(const float* c_in, const float* ada_w, const float* kv_ada_w, float* modp, int item, int lane) {
    const int cgp = item % (NTOT / 256), kc = item / (NTOT / 256);
    const int ng = cgp * 256;
    const float* base; int ld, n;
    if (ng < 4 * 6144) { const int mat = ng / 6144; base = ada_w + (size_t)mat * DM * 6144; ld = 6144; n = ng - mat * 6144; }
    else { base = kv_ada_w; ld = 4096; n = ng - 4 * 6144; }
    float cv[4][4];
#pragma unroll
    for (int b = 0; b < 4; ++b)
#pragma unroll
        for (int j = 0; j < 4; ++j) { const float x = c_in[b * DM + kc * 256 + j * 64 + lane]; cv[b][j] = x / (1.f + __expf(-x)); }
    f32x4 acc[4];
#pragma unroll
    for (int b = 0; b < 4; ++b) acc[b] = (f32x4){0.f, 0.f, 0.f, 0.f};
    const float* wp = base + (size_t)(kc * 256) * ld + n + 4 * lane;
#pragma unroll
    for (int j = 0; j < 4; ++j) {
#pragma unroll 8
        for (int kk = 0; kk < 64; ++kk) {
            const f32x4 w = *(const f32x4*)(wp + (size_t)(j * 64 + kk) * ld);
#pragma unroll
            for (int b = 0; b < 4; ++b) { const float s = __int_as_float(__builtin_amdgcn_readlane(__float_as_int(cv[b][j]), kk)); acc[b] += w * s; }
        }
    }
#pragma unroll
    for (int b = 0; b < 4; ++b) *(f32x4*)(modp + (size_t)(kc * 4 + b) * NTOT + ng + 4 * lane) = acc[b];
}

__device__ __forceinline__ float mod_val(const float* modp, int b, int col, float bias) {
    float s = bias;
#pragma unroll
    for (int kc = 0; kc < KC; ++kc) s += modp[(size_t)(kc * 4 + b) * NTOT + col];
    return s;
}

template <bool HAS_Y, bool WRITE_X, bool OUT1, bool OUT2>
__device__ __forceinline__ void row_pass(unsigned char* lds, const Args& args, const bf16_t* Y, const float* xin, float* xout, int mat_gate, int mat_next, bf16_t* H1, bf16_t* H2) {
    float* gp = (float*)lds; float* ap = gp + DM; float* sp = ap + DM; float* akv = sp + DM; float* skv = akv + DM;
    const float* modp = (const float*)(args.ws + WS_MODP);
    const int tid = threadIdx.x, lane = tid & 63, wave = tid >> 6;
    const int bx = blockIdx.x, b = bx >> 6;
    __syncthreads();
    for (int d = tid; d < DM; d += 512) {
        if (HAS_Y) gp[d] = mod_val(modp, b, mat_gate * 6144 + 4096 + d, args.in[I_ADAB][mat_gate * 6144 + 4096 + d]) * args.in[I_NPOST][mat_gate * DM + d];
        if (OUT1) { ap[d] = (1.f + mod_val(modp, b, mat_next * 6144 + 2048 + d, args.in[I_ADAB][mat_next * 6144 + 2048 + d])) * args.in[I_NPRE][mat_next * DM + d];
                    sp[d] = mod_val(modp, b, mat_next * 6144 + d, args.in[I_ADAB][mat_next * 6144 + d]); }
        if (OUT2) { akv[d] = (1.f + mod_val(modp, b, 4 * 6144 + 2048 + d, args.in[I_KVADAB][2048 + d])) * args.in[I_KVNORM][d];
                    skv[d] = mod_val(modp, b, 4 * 6144 + d, args.in[I_KVADAB][d]); }
    }
    __syncthreads();
    for (int i = 0; i < 8; ++i) {
        const size_t row = (size_t)bx * 64 + wave * 8 + i;
        f32x4 xv[8];
#pragma unroll
        for (int j = 0; j < 8; ++j) xv[j] = *(const f32x4*)(xin + row * DM + 256 * j + 4 * lane);
        if (HAS_Y) {
            u32x2 yv[8]; float ss = 0.f;
#pragma unroll
            for (int j = 0; j < 8; ++j) { yv[j] = *(const u32x2*)(Y + row * DM + 256 * j + 4 * lane);
                const float a = bf_lo(yv[j].x), bq = bf_hi(yv[j].x), c = bf_lo(yv[j].y), d = bf_hi(yv[j].y); ss += (a * a + bq * bq) + (c * c + d * d); }
            const float rstd = __builtin_amdgcn_rsqf(wave_sum(ss) * (1.f / DM) + EPS);
#pragma unroll
            for (int j = 0; j < 8; ++j) { const f32x4 g = *(const f32x4*)(gp + 256 * j + 4 * lane);
                const f32x4 y = {bf_lo(yv[j].x), bf_hi(yv[j].x), bf_lo(yv[j].y), bf_hi(yv[j].y)};
                xv[j] = xv[j] + (y * rstd) * g; }
        }
        if (WRITE_X) {
#pragma unroll
            for (int j = 0; j < 8; ++j) *(f32x4*)(xout + row * DM + 256 * j + 4 * lane) = xv[j];
        }
        if (OUT1 || OUT2) {
            float ss = 0.f;
#pragma unroll
            for (int j = 0; j < 8; ++j) ss += (xv[j][0] * xv[j][0] + xv[j][1] * xv[j][1]) + (xv[j][2] * xv[j][2] + xv[j][3] * xv[j][3]);
            const float rstd = __builtin_amdgcn_rsqf(wave_sum(ss) * (1.f / DM) + EPS);
            if (OUT1) {
#pragma unroll
                for (int j = 0; j < 8; ++j) { const f32x4 a = *(const f32x4*)(ap + 256 * j + 4 * lane), s = *(const f32x4*)(sp + 256 * j + 4 * lane);
                    const f32x4 h = (xv[j] * rstd) * a + s; u32x2 w; w.x = cvtpk(h[0], h[1]); w.y = cvtpk(h[2], h[3]); *(u32x2*)(H1 + row * DM + 256 * j + 4 * lane) = w; }
            }
            if (OUT2) {
#pragma unroll
                for (int j = 0; j < 8; ++j) { const f32x4 a = *(const f32x4*)(akv + 256 * j + 4 * lane), s = *(const f32x4*)(skv + 256 * j + 4 * lane);
                    const f32x4 h = (xv[j] * rstd) * a + s; u32x2 w; w.x = cvtpk(h[0], h[1]); w.y = cvtpk(h[2], h[3]); *(u32x2*)(H2 + row * DM + 256 * j + 4 * lane) = w; }
            }
        }
    }
}

__device__ __forceinline__ void conv_pass(const bf16_t* Z, const bf16_t* Bg, const float* cw, bf16_t* Gout) {
    const int gt = blockIdx.x * 512 + threadIdx.x;
    const int ch = (gt & 255) * 8, run = gt >> 8;
    const size_t r0 = (size_t)run * 32; const int s0 = (int)(r0 & (SEQ - 1));
    float w0[8], w1[8], w2[8];
#pragma unroll
    for (int e = 0; e < 8; ++e) { w0[e] = cw[ch + e]; w1[e] = cw[DM + ch + e]; w2[e] = cw[2 * DM + ch + e]; }
    float zm2[8], zm1[8];
    if (s0 == 0) {
#pragma unroll
        for (int e = 0; e < 8; ++e) { zm2[e] = 0.f; zm1[e] = 0.f; }
    } else {
        const u32x4 a = *(const u32x4*)(Z + (r0 - 2) * DM + ch), bq = *(const u32x4*)(Z + (r0 - 1) * DM + ch);
#pragma unroll
        for (int e = 0; e < 4; ++e) { zm2[2 * e] = bf_lo(a[e]); zm2[2 * e + 1] = bf_hi(a[e]); zm1[2 * e] = bf_lo(bq[e]); zm1[2 * e + 1] = bf_hi(bq[e]); }
    }
#pragma unroll 4
    for (int i = 0; i < 32; ++i) {
        const u32x4 zz = *(const u32x4*)(Z + (r0 + i) * DM + ch), bb = *(const u32x4*)(Bg + (r0 + i) * DM + ch);
        float z[8], o[8];
#pragma unroll
        for (int e = 0; e < 4; ++e) { z[2 * e] = bf_lo(zz[e]); z[2 * e + 1] = bf_hi(zz[e]); }
#pragma unroll
        for (int e = 0; e < 4; ++e) { o[2 * e] = bf_lo(bb[e]) * (w0[2 * e] * zm2[2 * e] + w1[2 * e] * zm1[2 * e] + w2[2 * e] * z[2 * e]);
                                      o[2 * e + 1] = bf_hi(bb[e]) * (w0[2 * e + 1] * zm2[2 * e + 1] + w1[2 * e + 1] * zm1[2 * e + 1] + w2[2 * e + 1] * z[2 * e + 1]); }
        u32x4 w; w.x = cvtpk(o[0], o[1]); w.y = cvtpk(o[2], o[3]); w.z = cvtpk(o[4], o[5]); w.w = cvtpk(o[6], o[7]);
        *(u32x4*)(Gout + (r0 + i) * DM + ch) = w;
#pragma unroll
        for (int e = 0; e < 8; ++e) { zm2[e] = zm1[e]; zm1[e] = z[e]; }
    }
}

constexpr int KROW = 144, VROW = 528;
constexpr int ALDS_K = 0, ALDS_V = 256 * KROW;
__device__ __forceinline__ int crow(int r, int hi) { return (r & 3) + 8 * (r >> 2) + 4 * hi; }
__device__ __forceinline__ void attn_phase(unsigned char* lds, const bf16_t* Q, const bf16_t* Kg, const bf16_t* Vtg, bf16_t* O, const float* sinks) {
    const int tid = threadIdx.x, lane = tid & 63, wave = tid >> 6, r = lane & 31, hi = lane >> 5;
    for (int unit = blockIdx.x; unit < NBATCH * 32 * NKV; unit += gridDim.x) {
        const int b = unit >> 7, nb = (unit >> 2) & 31, kvh = unit & 3;
        __syncthreads();
#pragma unroll
        for (int i = 0; i < 4; ++i) { const int id = tid + 512 * i, row = id >> 3, ch = id & 7, pos = (nb - 1) * 128 + row;
            u32x4 v = {0u, 0u, 0u, 0u}; if (pos >= 0) v = *(const u32x4*)(Kg + (size_t)(b * SEQ + pos) * 256 + kvh * 64 + ch * 8);
            *(u32x4*)(lds + ALDS_K + row * KROW + ch * 16) = v; }
#pragma unroll
        for (int i = 0; i < 4; ++i) { const int id = tid + 512 * i, d = id >> 5, ch = id & 31, key0 = (nb - 1) * 128 + ch * 8;
            u32x4 v = {0u, 0u, 0u, 0u}; if (key0 >= 0) v = *(const u32x4*)(Vtg + ((size_t)(b * NKV + kvh) * HD + d) * SEQ + key0);
            *(u32x4*)(lds + ALDS_V + d * VROW + ch * 16) = v; }
        __syncthreads();
        const int head = kvh * 8 + wave;
        const float sink = sinks[head] * LOG2E;
        for (int qg = 0; qg < 4; ++qg) {
            const size_t row = (size_t)b * SEQ + nb * 128 + qg * 32 + r;
            bf16x8 qf[4];
#pragma unroll
            for (int s = 0; s < 4; ++s) qf[s] = *(const bf16x8*)(Q + row * DM + head * 64 + 16 * s + 8 * hi);
            f32x16 st[5];
#pragma unroll
            for (int kt = 0; kt < 5; ++kt) {
                f32x16 a;
#pragma unroll
                for (int e = 0; e < 16; ++e) a[e] = 0.f;
#pragma unroll
                for (int s = 0; s < 4; ++s) { const bf16x8 kf = *(const bf16x8*)(lds + ALDS_K + (32 * (qg + kt) + r) * KROW + (16 * s + 8 * hi) * 2);
                    a = __builtin_amdgcn_mfma_f32_32x32x16_bf16(kf, qf[s], a, 0, 0, 0); }
                st[kt] = a;
            }
            float mx = sink;
#pragma unroll
            for (int kt = 0; kt < 5; ++kt)
#pragma unroll
                for (int e = 0; e < 16; ++e) {
                    const int diff = 32 * kt + crow(e, hi) - r;
                    bool valid = true;
                    if (kt == 0) valid = diff >= 1;
                    if (kt == 4) valid = diff <= 128;
                    if (nb == 0 && (qg + kt) < 4) valid = false;
                    const float s = valid ? st[kt][e] : -INFINITY;
                    st[kt][e] = s; mx = fmaxf(mx, s);
                }
            mx = fmaxf(mx, __shfl_xor(mx, 32));
            float l = 0.f;
#pragma unroll
            for (int kt = 0; kt < 5; ++kt)
#pragma unroll
                for (int e = 0; e < 16; ++e) { const float p = __builtin_amdgcn_exp2f(st[kt][e] - mx); st[kt][e] = p; l += p; }
            l += __shfl_xor(l, 32);
            l += __builtin_amdgcn_exp2f(sink - mx);
            f32x16 o0, o1;
#pragma unroll
            for (int e = 0; e < 16; ++e) { o0[e] = 0.f; o1[e] = 0.f; }
#pragma unroll
            for (int kt = 0; kt < 5; ++kt)
#pragma unroll
                for (int s2 = 0; s2 < 2; ++s2) {
                    u32x4 pw; pw.x = cvtpk(st[kt][8 * s2 + 0], st[kt][8 * s2 + 1]); pw.y = cvtpk(st[kt][8 * s2 + 2], st[kt][8 * s2 + 3]);
                    pw.z = cvtpk(st[kt][8 * s2 + 4], st[kt][8 * s2 + 5]); pw.w = cvtpk(st[kt][8 * s2 + 6], st[kt][8 * s2 + 7]);
                    const bf16x8 pf = __builtin_bit_cast(bf16x8, pw);
                    const int kb = 32 * (qg + kt) + 16 * s2 + 4 * hi;
                    const s16x4 lo0 = *(const s16x4*)(lds + ALDS_V + r * VROW + kb * 2), hi0 = *(const s16x4*)(lds + ALDS_V + r * VROW + (kb + 8) * 2);
                    const s16x4 lo1 = *(const s16x4*)(lds + ALDS_V + (32 + r) * VROW + kb * 2), hi1 = *(const s16x4*)(lds + ALDS_V + (32 + r) * VROW + (kb + 8) * 2);
                    const bf16x8 v0 = __builtin_shufflevector(lo0, hi0, 0, 1, 2, 3, 4, 5, 6, 7), v1 = __builtin_shufflevector(lo1, hi1, 0, 1, 2, 3, 4, 5, 6, 7);
                    o0 = __builtin_amdgcn_mfma_f32_32x32x16_bf16(v0, pf, o0, 0, 0, 0);
                    o1 = __builtin_amdgcn_mfma_f32_32x32x16_bf16(v1, pf, o1, 0, 0, 0);
                }
            const float il = 1.f / l;
            bf16_t* op = O + row * DM + head * 64 + 4 * hi;
#pragma unroll
            for (int ig = 0; ig < 4; ++ig) {
                u32x2 w0, w1;
                w0.x = cvtpk(o0[4 * ig] * il, o0[4 * ig + 1] * il); w0.y = cvtpk(o0[4 * ig + 2] * il, o0[4 * ig + 3] * il);
                w1.x = cvtpk(o1[4 * ig] * il, o1[4 * ig + 1] * il); w1.y = cvtpk(o1[4 * ig + 2] * il, o1[4 * ig + 3] * il);
                *(u32x2*)(op + 8 * ig) = w0; *(u32x2*)(op + 32 + 8 * ig) = w1;
            }
        }
    }
}

__device__ __forceinline__ float rope_inv(int i) {
    return i == 0 ? 1.0f : i == 1 ? 0.1939227432012558f : i == 2 ? 0.03760603070259094f : i == 3 ? 0.007292664609849453f :
           i == 4 ? 0.0014142135623842478f : i == 5 ? 0.00027424818836152554f : i == 6 ? 5.3182957344688475e-05f : 1.0313385246263351e-05f;
}

__device__ __forceinline__ void prologue(unsigned char* lds, const Args& args) {
    const int tid = threadIdx.x, lane = tid & 63, wave = tid >> 6;
    const int G = gridDim.x, bx = blockIdx.x;
    const int vcu = (G % 8 == 0) ? (bx % 8) * (G / 8) + bx / 8 : bx;
    const int gw = vcu * NWAVES + wave, NGW = G * NWAVES;
    unsigned char* ws = args.ws;
    { const int id = bx * 512 + tid;
      if (id < SEQ * 8) { const int pos = id >> 3, i = id & 7; const float ang = (float)pos * rope_inv(i);
          const double rev = (double)ang * 0.15915494309189535; const float fr = (float)(rev - floor(rev));
          float* rp = (float*)(ws + WS_ROPE) + pos * 16; rp[i] = __builtin_amdgcn_cosf(fr); rp[8 + i] = __builtin_amdgcn_sinf(fr); } }
    for (int it = gw; it < (NTOT / 256) * KC; it += NGW) gemv_item(args.in[I_C], args.in[I_ADAW], args.in[I_KVADAW], (float*)(ws + WS_MODP), it, lane);
    LAS float* scr = (LAS float*)((LAS unsigned char*)lds + wave * 16384);
    constexpr int I_IN = 32 * 192, I_OUT = 32 * 64, I_UPI = 32 * 256, I_DN = 128 * 64, I_Q = 32 * 64, I_KV = 32 * 16, I_O = 32 * 64;
    constexpr int NITEMS = I_IN + I_OUT + 2 * I_UPI + 2 * I_DN + I_Q + I_KV + I_O;
    for (int it = gw; it < NITEMS; it += NGW) {
        int q = it;
        if (q < I_IN) { transpose_item(args.in[I_CWIN], DM, 3 * DM, (bf16_t*)(ws + WS_WIN), q, 1, scr, lane); continue; } q -= I_IN;
        if (q < I_OUT) { transpose_item(args.in[I_CWOUT], DM, DM, (bf16_t*)(ws + WS_WOUT), q, 0, scr, lane); continue; } q -= I_OUT;
        if (q < I_UPI) { transpose_item(args.in[I_UP], DM, DFF, (bf16_t*)(ws + WS_WUP0), q, 0, scr, lane); continue; } q -= I_UPI;
        if (q < I_UPI) { transpose_item(args.in[I_UP] + (size_t)DM * DFF, DM, DFF, (bf16_t*)(ws + WS_WUP1), q, 0, scr, lane); continue; } q -= I_UPI;
        if (q < I_DN) { transpose_item(args.in[I_DOWN], DFF, DM, (bf16_t*)(ws + WS_WDN0), q, 0, scr, lane); continue; } q -= I_DN;
        if (q < I_DN) { transpose_item(args.in[I_DOWN] + (size_t)DM * DFF, DFF, DM, (bf16_t*)(ws + WS_WDN1), q, 0, scr, lane); continue; } q -= I_DN;
        if (q < I_Q) { transpose_item(args.in[I_WQ], DM, DM, (bf16_t*)(ws + WS_WQ), q, 0, scr, lane); continue; } q -= I_Q;
        if (q < I_KV) { transpose_item(args.in[I_WKV], DM, 512, (bf16_t*)(ws + WS_WKV), q, 0, scr, lane); continue; } q -= I_KV;
        transpose_item(args.in[I_WO], DM, DM, (bf16_t*)(ws + WS_WO), q, 0, scr, lane);
    }
}

constexpr int N_PHASES = 16;
__global__ void __launch_bounds__(NWAVES * 64, 2) yoco_fwd(Args args) {
    extern __shared__ __attribute__((aligned(16))) unsigned char lds[];
    unsigned char* ws = args.ws;
    const int G = gridDim.x;
    const int lo = args.ph_lo, hi = args.ph_hi;
    LAS unsigned char* ldsg = (LAS unsigned char*)lds;
#if MK_XCD_BAR
    volatile LAS unsigned* misc = (volatile LAS unsigned*)(ldsg + 131072);
    if (threadIdx.x < 2) misc[threadIdx.x] = 0u;
    __syncthreads();
    XcdBarrier bar = xcd_barrier_post((unsigned*)(ws + WS_CTL) + 1024, misc);
    int nsync = 0;
#define GRID_BAR() do { if (nsync == 0) cg::this_grid().sync(); else xcd_barrier(bar); ++nsync; } while (0)
#else
#define GRID_BAR() cg::this_grid().sync()
#endif
#define IN(k) (lo <= (k) && (k) < hi)
#define SEAM(k) do { if (IN(k) && IN((k) + 1)) GRID_BAR(); } while (0)
    bf16_t* H = (bf16_t*)(ws + WS_H); bf16_t* ZQ = (bf16_t*)(ws + WS_ZQ); bf16_t* BO = (bf16_t*)(ws + WS_BO); bf16_t* GK = (bf16_t*)(ws + WS_GK);
    bf16_t* A = (bf16_t*)(ws + WS_A); bf16_t* Kb = (bf16_t*)(ws + WS_K); bf16_t* Vt = (bf16_t*)(ws + WS_VT);
    const float* rope = (const float*)(ws + WS_ROPE);
    pg8::StaticOrder S;

    if (IN(0)) { prologue(lds, args); } SEAM(0);
    if (IN(1)) { row_pass<false, false, true, false>(lds, args, nullptr, args.in[I_X], nullptr, 0, 0, H, nullptr); } SEAM(1);
    if (IN(2)) { pg8::Gemm g{H, (const bf16_t*)(ws + WS_WIN), T, 3 * DM, DM}; S.init(T, 3 * DM, G, (int)blockIdx.x); pg8::EpiZB E{ZQ, BO};
        pg8::gemm_phase<pg8::EpiZB, pg8::StaticOrder, true, true>(ldsg, g, S, E); } SEAM(2);
    if (IN(3)) { conv_pass(ZQ, BO, args.in[I_CONVW], GK); } SEAM(3);
    if (IN(4)) { pg8::Gemm g{GK, (const bf16_t*)(ws + WS_WOUT), T, DM, DM}; S.init(T, DM, G, (int)blockIdx.x); pg8::EpiBf16<0> E{H, DM, nullptr};
        pg8::gemm_phase<pg8::EpiBf16<0>, pg8::StaticOrder, true, true>(ldsg, g, S, E); } SEAM(4);
    if (IN(5)) { row_pass<true, true, true, false>(lds, args, H, args.in[I_X], args.out, 0, 1, H, nullptr); } SEAM(5);
    if (IN(6)) { pg8::Gemm g{H, (const bf16_t*)(ws + WS_WUP0), T, DFF, DM}; S.init(T, DFF, G, (int)blockIdx.x); pg8::EpiBf16<1> E{A, DFF, nullptr};
        pg8::gemm_phase<pg8::EpiBf16<1>, pg8::StaticOrder, true, true>(ldsg, g, S, E); } SEAM(6);
    if (IN(7)) { pg8::Gemm g{A, (const bf16_t*)(ws + WS_WDN0), T, DM, DFF}; S.init(T, DM, G, (int)blockIdx.x); pg8::EpiBf16<0> E{H, DM, nullptr};
        pg8::gemm_phase<pg8::EpiBf16<0>, pg8::StaticOrder, true, true>(ldsg, g, S, E); } SEAM(7);
    if (IN(8)) { row_pass<true, true, true, true>(lds, args, H, args.out, args.out, 1, 2, H, GK); } SEAM(8);
    if (IN(9)) {
        { pg8::Gemm g{H, (const bf16_t*)(ws + WS_WQ), T, DM, DM}; S.init(T, DM, G, (int)blockIdx.x); pg8::EpiQ E{ZQ, args.in[I_BQ], rope};
          pg8::gemm_phase<pg8::EpiQ, pg8::StaticOrder, true, true>(ldsg, g, S, E); }
        { pg8::Gemm g{GK, (const bf16_t*)(ws + WS_WKV), T, 512, DM}; S.init(T, 512, G, (int)blockIdx.x); pg8::EpiKV E{Kb, Vt, args.in[I_BKV], rope};
          pg8::gemm_phase<pg8::EpiKV, pg8::StaticOrder, true, true>(ldsg, g, S, E); }
    } SEAM(9);
    if (IN(10)) { attn_phase(lds, ZQ, Kb, Vt, BO, args.in[I_SINKS]); } SEAM(10);
    if (IN(11)) { pg8::Gemm g{BO, (const bf16_t*)(ws + WS_WO), T, DM, DM}; S.init(T, DM, G, (int)blockIdx.x); pg8::EpiBf16<0> E{H, DM, args.in[I_BO]};
        pg8::gemm_phase<pg8::EpiBf16<0>, pg8::StaticOrder, true, true>(ldsg, g, S, E); } SEAM(11);
    if (IN(12)) { row_pass<true, true, true, false>(lds, args, H, args.out, args.out, 2, 3, H, nullptr); } SEAM(12);
    if (IN(13)) { pg8::Gemm g{H, (const bf16_t*)(ws + WS_WUP1), T, DFF, DM}; S.init(T, DFF, G, (int)blockIdx.x); pg8::EpiBf16<1> E{A, DFF, nullptr};
        pg8::gemm_phase<pg8::EpiBf16<1>, pg8::StaticOrder, true, true>(ldsg, g, S, E); } SEAM(13);
    if (IN(14)) { pg8::Gemm g{A, (const bf16_t*)(ws + WS_WDN1), T, DM, DFF}; S.init(T, DM, G, (int)blockIdx.x); pg8::EpiBf16<0> E{H, DM, nullptr};
        pg8::gemm_phase<pg8::EpiBf16<0>, pg8::StaticOrder, true, true>(ldsg, g, S, E); } SEAM(14);
    if (IN(15)) { row_pass<true, true, false, false>(lds, args, H, args.out, args.out, 3, 0, nullptr, nullptr); }
#undef IN
#undef SEAM
}

extern "C" void kernel_launch(void* const* d_in, const int* in_sizes, int n_in, void* d_out, int out_size, void* d_ws, size_t ws_size, hipStream_t stream) {
    static int grid = 0;
    if (grid == 0) {
        if (n_in != 21 || in_sizes[0] != T * DM || out_size != T * DM || ws_size < WS_END) { fprintf(stderr, "kernel_launch: unexpected shapes (n_in %d, in0 %d, out %d, ws %zu); nothing launched\n", n_in, n_in > 0 ? in_sizes[0] : -1, out_size, ws_size); grid = -1; return; }
        int dev = 0, cus = 0, per_cu = 0;
        if (hipGetDevice(&dev) != hipSuccess || hipDeviceGetAttribute(&cus, hipDeviceAttributeMultiprocessorCount, dev) != hipSuccess) { grid = -1; return; }
        if (hipFuncSetAttribute((const void*)yoco_fwd, hipFuncAttributeMaxDynamicSharedMemorySize, LDS_BYTES) != hipSuccess) { fprintf(stderr, "kernel_launch: hipFuncSetAttribute failed\n"); grid = -1; return; }
        if (hipOccupancyMaxActiveBlocksPerMultiprocessor(&per_cu, (const void*)yoco_fwd, NWAVES * 64, LDS_BYTES) != hipSuccess || per_cu < 1) { fprintf(stderr, "kernel_launch: occupancy query says %d\n", per_cu); per_cu = 1; }
        (void)hipGetLastError();
        grid = cus * 1;
        if (grid != 256) { fprintf(stderr, "kernel_launch: built for a 256-CU device, found %d CUs\n", cus); grid = -1; return; }
    }
    if (grid < 0) return;
    Args a{};
    for (int i = 0; i < 21; ++i) a.in[i] = (const float*)d_in[i];
    a.out = (float*)d_out; a.ws = (unsigned char*)d_ws;
    if (MK_N_LAUNCHES == 1) {
        (void)hipMemsetAsync((char*)d_ws + WS_CTL, 0, CTL_ZERO_BYTES, stream);
        a.ph_lo = 0; a.ph_hi = N_PHASES;
        void* kargs[] = {&a};
        hipError_t e = hipLaunchCooperativeKernel((const void*)yoco_fwd, dim3(grid), dim3(NWAVES * 64), kargs, LDS_BYTES, stream);
        if (e != hipSuccess) fprintf(stderr, "kernel_launch: cooperative launch failed: %s\n", hipGetErrorString(e));
    } else {
        for (int p = 0; p < N_PHASES; ++p) { a.ph_lo = p; a.ph_hi = p + 1; hipLaunchKernelGGL(yoco_fwd, dim3(grid), dim3(NWAVES * 64), LDS_BYTES, stream, a); }
    }
}
```

```cpp
#include <hip/hip_runtime.h>
#include <hip/hip_cooperative_groups.h>
#include <cstdio>
#include <cstdint>
#include <cmath>
namespace cg = cooperative_groups;

#ifndef MK_N_LAUNCHES
#define MK_N_LAUNCHES 1
#endif
#ifndef MK_XCD_BAR
#define MK_XCD_BAR 1
#endif

#define LAS __attribute__((address_space(3)))
typedef unsigned short bf16_t;
typedef short bf16x8 __attribute__((ext_vector_type(8)));
typedef short s16x4 __attribute__((ext_vector_type(4)));
typedef float f32x4 __attribute__((ext_vector_type(4)));
typedef float f32x16 __attribute__((ext_vector_type(16)));
typedef unsigned u32x4 __attribute__((ext_vector_type(4)));
typedef unsigned u32x2 __attribute__((ext_vector_type(2)));
typedef float f32x2_t __attribute__((ext_vector_type(2)));
typedef __bf16 bf16x2_t __attribute__((ext_vector_type(2)));

constexpr int DM = 2048, NBATCH = 4, SEQ = 4096, T = NBATCH * SEQ, DFF = 8192, NH = 32, NKV = 4, HD = 64;
constexpr int NTOT = 4 * 6144 + 4096;
constexpr int KC = 8;
constexpr float EPS = 1e-6f;
constexpr float LOG2E = 1.4426950408889634f;
constexpr float QSCALE = 0.125f * LOG2E;

constexpr size_t MiB = 1u << 20;
constexpr size_t WS_CTL = 0, CTL_ZERO_BYTES = 64 * 1024;
constexpr size_t WS_MODP = 1 * MiB;
constexpr size_t WS_ROPE = 5 * MiB;
constexpr size_t WS_WIN = 8 * MiB, WS_WOUT = 32 * MiB, WS_WUP0 = 40 * MiB, WS_WUP1 = 72 * MiB, WS_WDN0 = 104 * MiB, WS_WDN1 = 136 * MiB;
constexpr size_t WS_WQ = 168 * MiB, WS_WKV = 176 * MiB, WS_WO = 178 * MiB;
constexpr size_t WS_H = 192 * MiB;
constexpr size_t WS_ZQ = 256 * MiB;
constexpr size_t WS_BO = 320 * MiB;
constexpr size_t WS_GK = 384 * MiB;
constexpr size_t WS_A = 448 * MiB;
constexpr size_t WS_K = 704 * MiB;
constexpr size_t WS_VT = 712 * MiB;
constexpr size_t WS_END = 720 * MiB;

constexpr int LDS_BYTES = 147456;
constexpr int NWAVES = 8;

__device__ __forceinline__ unsigned cvtpk(float lo, float hi) { f32x2_t v = {lo, hi}; bf16x2_t b = __builtin_convertvector(v, bf16x2_t); return __builtin_bit_cast(unsigned, b); }
__device__ __forceinline__ float bf_lo(unsigned u) { return __uint_as_float(u << 16); }
__device__ __forceinline__ float bf_hi(unsigned u) { return __uint_as_float(u & 0xffff0000u); }
__device__ __forceinline__ void st8(bf16_t* p, f32x4 v0, f32x4 v1) { u32x4 w; w.x = cvtpk(v0[0], v0[1]); w.y = cvtpk(v0[2], v0[3]); w.z = cvtpk(v1[0], v1[1]); w.w = cvtpk(v1[2], v1[3]); *(u32x4*)p = w; }

namespace pg8 {
#define PG8_LAS __attribute__((address_space(3)))
constexpr int BM = 256, BK = 64, HALF = 128, HTB = HALF * BK * 2, STAGE_BYTES = 8 * HTB, NXCD = 8, WGM = 8;
__host__ __device__ __forceinline__ int lds_byte(int r, int c) { const int st = (r >> 4) * 2 + (c >> 5), rr = r & 15, cc = c & 31, ob = rr * 64 + cc * 2; return st * 1024 + (ob ^ (((ob >> 9) & 1) << 5)); }
__host__ __device__ __forceinline__ void stage_rc(int b, int& R, int& C) { const int st = b / 1024, sb = b % 1024, swz = sb ^ (((sb >> 9) & 1) << 5); R = (st >> 1) * 16 + swz / 64; C = (st & 1) * 32 + (swz % 64) / 2; }
__host__ __device__ __forceinline__ int perm32(int rho) { const int n = rho >> 4, i = rho & 15; return 8 * (i >> 2) + 4 * n + (i & 3); }

struct Unit { int pm, pn; };
struct Gemm { const bf16_t* A; const bf16_t* Bt; int M, N, K; };
struct StaticOrder {
    int nM, nN, nwg, G, c;
    __host__ __device__ void init(int M, int N, int G_, int c_) { nM = M / BM; nN = N / BM; nwg = nM * nN; G = G_; c = c_; }
    __host__ __device__ bool next(int i, Unit& u) const {
        const long L = (long)i * G + c; if (L >= nwg) return false;
        int wgid = (int)L; { const int q = nwg / NXCD, r = nwg % NXCD, xcd = wgid % NXCD, off = wgid / NXCD; wgid = (xcd < r ? xcd * (q + 1) : r * (q + 1) + (xcd - r) * q) + off; }
        const int nig = WGM * nN, gid = wgid / nig, fm = gid * WGM, gsz = (nM - fm) < WGM ? (nM - fm) : WGM;
        u.pm = fm + ((wgid % nig) % gsz); u.pn = (wgid % nig) / gsz; return true;
    }
};


template <int ACT> struct EpiBf16 {
    bf16_t* O; int ldc; const float* bias;
    __device__ __forceinline__ void operator()(const f32x4 (&acc)[2][2][4][2], const Unit& u, int wr, int wc, int fr, int fq) const {
        const int row0 = u.pm * BM + wr * 64 + fr, col0 = u.pn * BM + wc * 32 + 8 * fq;
        f32x4 bv[2][2];
#pragma unroll
        for (int bj = 0; bj < 2; ++bj)
#pragma unroll
            for (int n = 0; n < 2; ++n) bv[bj][n] = bias ? *(const f32x4*)(bias + col0 + bj * HALF + 4 * n) : (f32x4){0.f, 0.f, 0.f, 0.f};
#pragma unroll
        for (int ai = 0; ai < 2; ++ai)
#pragma unroll
            for (int m = 0; m < 4; ++m) { bf16_t* rowp = O + (size_t)(row0 + ai * HALF + m * 16) * ldc + col0;
#pragma unroll
                for (int bj = 0; bj < 2; ++bj) { f32x4 v0 = acc[ai][bj][m][0] + bv[bj][0], v1 = acc[ai][bj][m][1] + bv[bj][1];
                    if (ACT == 1) { v0 = __builtin_elementwise_max(v0, (f32x4){0.f, 0.f, 0.f, 0.f}); v1 = __builtin_elementwise_max(v1, (f32x4){0.f, 0.f, 0.f, 0.f}); v0 = v0 * v0; v1 = v1 * v1; }
                    st8(rowp + bj * HALF, v0, v1); } }
    }
};
struct EpiZB {
    bf16_t* Z; bf16_t* Bg;
    __device__ __forceinline__ void operator()(const f32x4 (&acc)[2][2][4][2], const Unit& u, int wr, int wc, int fr, int fq) const {
        const int row0 = u.pm * BM + wr * 64 + fr;
        if (u.pn < 16) {
            const int col0 = u.pn * HALF + wc * 32 + 8 * fq;
#pragma unroll
            for (int ai = 0; ai < 2; ++ai)
#pragma unroll
                for (int m = 0; m < 4; ++m) st8(Z + (size_t)(row0 + ai * HALF + m * 16) * DM + col0, acc[ai][0][m][0] * acc[ai][1][m][0], acc[ai][0][m][1] * acc[ai][1][m][1]);
        } else {
            const int col0 = (u.pn - 16) * BM + wc * 32 + 8 * fq;
#pragma unroll
            for (int ai = 0; ai < 2; ++ai)
#pragma unroll
                for (int m = 0; m < 4; ++m)
#pragma unroll
                    for (int bj = 0; bj < 2; ++bj) st8(Bg + (size_t)(row0 + ai * HALF + m * 16) * DM + col0 + bj * HALF, acc[ai][bj][m][0], acc[ai][bj][m][1]);
        }
    }
};
__device__ __forceinline__ void rope8(f32x4& v0, f32x4& v1, const float* rope, int pos, int fq) {
    f32x4 p0, p1;
#pragma unroll
    for (int e = 0; e < 4; ++e) { p0[e] = __shfl_xor(v0[e], 16); p1[e] = __shfl_xor(v1[e], 16); }
    if (fq < 2) {
        const float* rp = rope + (size_t)pos * 16;
        const f32x4 c0 = *(const f32x4*)(rp), c1 = *(const f32x4*)(rp + 4), s0 = *(const f32x4*)(rp + 8), s1 = *(const f32x4*)(rp + 12);
        if (fq == 0) { v0 = v0 * c0 - p0 * s0; v1 = v1 * c1 - p1 * s1; }
        else         { v0 = v0 * c0 + p0 * s0; v1 = v1 * c1 + p1 * s1; }
    }
}
struct EpiQ {
    bf16_t* O; const float* bias; const float* rope;
    __device__ __forceinline__ void operator()(const f32x4 (&acc)[2][2][4][2], const Unit& u, int wr, int wc, int fr, int fq) const {
        const int row0 = u.pm * BM + wr * 64 + fr, col0 = u.pn * BM + wc * 32 + 8 * fq;
#pragma unroll
        for (int ai = 0; ai < 2; ++ai)
#pragma unroll
            for (int m = 0; m < 4; ++m) { const int row = row0 + ai * HALF + m * 16;
#pragma unroll
                for (int bj = 0; bj < 2; ++bj) {
                    f32x4 v0 = acc[ai][bj][m][0] + *(const f32x4*)(bias + col0 + bj * HALF), v1 = acc[ai][bj][m][1] + *(const f32x4*)(bias + col0 + bj * HALF + 4);
                    if ((wc & 1) == 0) rope8(v0, v1, rope, row & (SEQ - 1), fq);
                    st8(O + (size_t)row * DM + col0 + bj * HALF, v0 * QSCALE, v1 * QSCALE); } }
    }
};
struct EpiKV {
    bf16_t* Kb; bf16_t* Vt; const float* bias; const float* rope;
    __device__ __forceinline__ void operator()(const f32x4 (&acc)[2][2][4][2], const Unit& u, int wr, int wc, int fr, int fq) const {
        const int row0 = u.pm * BM + wr * 64 + fr, colt = wc * 32 + 8 * fq;
#pragma unroll
        for (int ai = 0; ai < 2; ++ai)
#pragma unroll
            for (int m = 0; m < 4; ++m) { const int row = row0 + ai * HALF + m * 16, pos = row & (SEQ - 1), b = row / SEQ;
#pragma unroll
                for (int bj = 0; bj < 2; ++bj) { const int col = colt + bj * HALF;
                    f32x4 v0 = acc[ai][bj][m][0] + *(const f32x4*)(bias + u.pn * BM + col), v1 = acc[ai][bj][m][1] + *(const f32x4*)(bias + u.pn * BM + col + 4);
                    if (u.pn == 0) { if ((wc & 1) == 0) rope8(v0, v1, rope, pos, fq); st8(Kb + (size_t)row * 256 + col, v0, v1); }
                    else { const int kvh = col >> 6, d = col & 63; bf16_t* vp = Vt + ((size_t)(b * NKV + kvh) * HD + d) * SEQ + pos;
#pragma unroll
                        for (int e = 0; e < 4; ++e) { vp[(size_t)e * SEQ] = (bf16_t)(cvtpk(v0[e], 0.f) & 0xffffu); vp[(size_t)(e + 4) * SEQ] = (bf16_t)(cvtpk(v1[e], 0.f) & 0xffffu); } } } }
    }
};

template <class Epi, class Sched, bool ALIGN_EPI = false, bool SP2 = false>
__device__ __forceinline__ void gemm_phase(PG8_LAS unsigned char* lds, const Gemm g, const Sched& S, const Epi& E) {
    const int tid = threadIdx.x, wid = __builtin_amdgcn_readfirstlane(tid >> 6), lane = tid & 63, wr = wid >> 2, wc = wid & 3, fr = lane & 15, fq = lane >> 4;
    const int K = g.K, nt = K / BK;
    unsigned voffA[2], voffB[2];
#pragma unroll
    for (int i = 0; i < 2; ++i) { int R, C; stage_rc(tid * 16 + i * 8192, R, C); const int Rb = (R & ~31) + perm32(R & 31);
        voffA[i] = (unsigned)(R * K + C) * 2u; voffB[i] = (unsigned)(Rb * K + C) * 2u; }
    const size_t kstep = (size_t)(BK * 2);
    const size_t hstep = (size_t)HALF * K * 2;
    const size_t tstep = 2 * hstep;
    const unsigned ldsw = (unsigned)wid * 1024u;
    const int aoff = lds_byte(wr * 64 + fr, fq * 8), boff = lds_byte(wc * 32 + fr, fq * 8);
#define PG8_SA(b, h) (((b) * 2 + (h)) * HTB)
#define PG8_SB(b, h) ((4 + (b) * 2 + (h)) * HTB)
#define PG8_STAGE(bufoff, gbase, voff) do { _Pragma("unroll") for (int _i = 0; _i < 2; ++_i) \
        __builtin_amdgcn_global_load_lds((const unsigned*)((const char*)(gbase) + (voff)[_i]), (PG8_LAS unsigned*)(lds + (bufoff) + ldsw + _i * 8192), 16, 0, 0); } while (0)
#define PG8_LDA(dst, b, h) do { _Pragma("unroll") for (int m = 0; m < 4; ++m) _Pragma("unroll") for (int k = 0; k < 2; ++k) dst[m][k] = *(const PG8_LAS bf16x8*)(lds + PG8_SA(b, h) + aoff + m * 2048 + k * 1024); } while (0)
#define PG8_LDB(dst, b, h) do { _Pragma("unroll") for (int n = 0; n < 2; ++n) _Pragma("unroll") for (int k = 0; k < 2; ++k) dst[n][k] = *(const PG8_LAS bf16x8*)(lds + PG8_SB(b, h) + boff + n * 2048 + k * 1024); } while (0)
#define PG8_MMA(ai, bj, At, Bt) do { __builtin_amdgcn_s_setprio(1); _Pragma("unroll") for (int m = 0; m < 4; ++m) _Pragma("unroll") for (int n = 0; n < 2; ++n) _Pragma("unroll") for (int k = 0; k < 2; ++k) \
        acc[ai][bj][m][n] = __builtin_amdgcn_mfma_f32_16x16x32_bf16(Bt[n][k], At[m][k], acc[ai][bj][m][n], 0, 0, 0); __builtin_amdgcn_s_setprio(0); } while (0)
#define PG8_WAIT_V(n) asm volatile("s_waitcnt vmcnt(" #n ")" ::: "memory")
#define PG8_WAIT_L(n) asm volatile("s_waitcnt lgkmcnt(" #n ")" ::: "memory")
#define PG8_BAR __builtin_amdgcn_s_barrier()
#define PG8_SCHED __builtin_amdgcn_sched_barrier(0)
    Unit cur, nxt; int ui = 0;
    if (!S.next(0, cur)) return;
    f32x4 acc[2][2][4][2];
#pragma unroll
    for (int a = 0; a < 2; ++a)
#pragma unroll
        for (int b = 0; b < 2; ++b)
#pragma unroll
            for (int m = 0; m < 4; ++m)
#pragma unroll
                for (int n = 0; n < 2; ++n) acc[a][b][m][n] = (f32x4){0.f, 0.f, 0.f, 0.f};
    bf16x8 At[4][2], B0[2][2], B1[2][2];
    const char* cA = (const char*)g.A + (size_t)cur.pm * tstep; const char* cB = (const char*)g.Bt + (size_t)cur.pn * tstep;
    if constexpr (SP2) {
        PG8_STAGE(PG8_SB(0, 0), cB, voffB); PG8_STAGE(PG8_SB(0, 1), cB + hstep, voffB); PG8_STAGE(PG8_SA(0, 0), cA, voffA); PG8_STAGE(PG8_SA(0, 1), cA + hstep, voffA);
        if (wr == 1) PG8_BAR;
        PG8_WAIT_V(2); PG8_BAR;
        PG8_STAGE(PG8_SB(1, 0), cB + kstep, voffB); PG8_STAGE(PG8_SA(1, 0), cA + kstep, voffA); PG8_STAGE(PG8_SB(1, 1), cB + hstep + kstep, voffB);
        PG8_WAIT_V(6); PG8_BAR;
    } else {
        PG8_STAGE(PG8_SB(0, 0), cB, voffB); PG8_STAGE(PG8_SA(0, 0), cA, voffA); PG8_STAGE(PG8_SB(0, 1), cB + hstep, voffB); PG8_STAGE(PG8_SA(0, 1), cA + hstep, voffA);
        if (wr == 1) PG8_BAR;
        PG8_WAIT_V(4); PG8_BAR;
        PG8_STAGE(PG8_SB(1, 0), cB + kstep, voffB); PG8_STAGE(PG8_SA(1, 0), cA + kstep, voffA); PG8_STAGE(PG8_SB(1, 1), cB + hstep + kstep, voffB);
        PG8_WAIT_V(6); PG8_BAR;
    }
    for (;;) {
        const bool has_next = S.next(ui + 1, nxt);
        const char* nA = has_next ? (const char*)g.A + (size_t)nxt.pm * tstep : cA; const char* nB = has_next ? (const char*)g.Bt + (size_t)nxt.pn * tstep : cB;
        for (int t = 0; t < nt; t += 2) {
            const bool last = (t == nt - 2);
            const char* a1 = cA + (size_t)(t + 1) * kstep;
            const char* a2 = last ? nA : cA + (size_t)(t + 2) * kstep; const char* b2 = last ? nB : cB + (size_t)(t + 2) * kstep;
            const char* a3 = a2 + kstep; const char* b3 = b2 + kstep;
            if constexpr (SP2) {
            PG8_LDB(B0, 0, 0); PG8_LDB(B1, 0, 1); PG8_SCHED; PG8_LDA(At, 0, 0); PG8_STAGE(PG8_SA(1, 1), a1 + hstep, voffA);
            PG8_WAIT_V(8); PG8_WAIT_L(0); PG8_BAR; PG8_MMA(0, 0, At, B0); PG8_MMA(0, 1, At, B1); PG8_BAR; PG8_SCHED;
            PG8_LDA(At, 0, 1); PG8_STAGE(PG8_SB(0, 0), b2, voffB); PG8_STAGE(PG8_SB(0, 1), b2 + hstep, voffB); PG8_STAGE(PG8_SA(0, 0), a2, voffA);
            PG8_WAIT_V(8); PG8_WAIT_L(0); PG8_BAR; PG8_MMA(1, 0, At, B0); PG8_MMA(1, 1, At, B1); PG8_BAR; PG8_SCHED;
            PG8_LDB(B0, 1, 0); PG8_LDB(B1, 1, 1); PG8_SCHED; PG8_LDA(At, 1, 0); PG8_STAGE(PG8_SA(0, 1), a2 + hstep, voffA);
            PG8_WAIT_V(8); PG8_WAIT_L(0); PG8_BAR; PG8_MMA(0, 0, At, B0); PG8_MMA(0, 1, At, B1); PG8_BAR; PG8_SCHED;
            PG8_LDA(At, 1, 1); PG8_STAGE(PG8_SB(1, 0), b3, voffB); PG8_STAGE(PG8_SB(1, 1), b3 + hstep, voffB); PG8_STAGE(PG8_SA(1, 0), a3, voffA);
            PG8_WAIT_V(8); PG8_WAIT_L(0); PG8_BAR; PG8_MMA(1, 0, At, B0); PG8_MMA(1, 1, At, B1); PG8_BAR; PG8_SCHED;
            } else {
            PG8_LDB(B0, 0, 0); PG8_SCHED; PG8_LDA(At, 0, 0); PG8_STAGE(PG8_SA(1, 1), a1 + hstep, voffA);
            PG8_WAIT_L(8); PG8_BAR; PG8_WAIT_L(0); PG8_MMA(0, 0, At, B0); PG8_BAR; PG8_SCHED;
            PG8_LDB(B1, 0, 1); PG8_STAGE(PG8_SB(0, 0), b2, voffB);
            PG8_BAR; PG8_WAIT_L(0); PG8_MMA(0, 1, At, B1); PG8_BAR;
            PG8_LDA(At, 0, 1); PG8_STAGE(PG8_SA(0, 0), a2, voffA);
            PG8_BAR; PG8_WAIT_L(0); PG8_MMA(1, 0, At, B0); PG8_BAR; PG8_SCHED;
            PG8_STAGE(PG8_SB(0, 1), b2 + hstep, voffB);
            PG8_WAIT_V(6); PG8_BAR; PG8_MMA(1, 1, At, B1); PG8_BAR;
            PG8_LDB(B0, 1, 0); PG8_SCHED; PG8_LDA(At, 1, 0); PG8_STAGE(PG8_SA(0, 1), a2 + hstep, voffA);
            PG8_WAIT_L(8); PG8_BAR; PG8_WAIT_L(0); PG8_MMA(0, 0, At, B0); PG8_BAR; PG8_SCHED;
            PG8_LDB(B1, 1, 1); PG8_STAGE(PG8_SB(1, 0), b3, voffB);
            PG8_BAR; PG8_WAIT_L(0); PG8_MMA(0, 1, At, B1); PG8_BAR;
            PG8_LDA(At, 1, 1); PG8_STAGE(PG8_SA(1, 0), a3, voffA);
            PG8_BAR; PG8_WAIT_L(0); PG8_MMA(1, 0, At, B0); PG8_BAR; PG8_SCHED;
            PG8_STAGE(PG8_SB(1, 1), b3 + hstep, voffB);
            PG8_WAIT_V(6); PG8_BAR; PG8_MMA(1, 1, At, B1); PG8_BAR;
            }
        }
        if constexpr (ALIGN_EPI) { if (wr == 0) PG8_BAR; }
        E(acc, cur, wr, wc, fr, fq);
        if (!has_next) break;
#pragma unroll
        for (int a = 0; a < 2; ++a)
#pragma unroll
            for (int b = 0; b < 2; ++b)
#pragma unroll
                for (int m = 0; m < 4; ++m)
#pragma unroll
                    for (int n = 0; n < 2; ++n) acc[a][b][m][n] = (f32x4){0.f, 0.f, 0.f, 0.f};
        cur = nxt; cA = nA; cB = nB; ++ui;
        if constexpr (ALIGN_EPI) { if (wr == 1) PG8_BAR; }
    }
    PG8_WAIT_V(0);
    if constexpr (!ALIGN_EPI) { if (wr == 0) PG8_BAR; }
    PG8_BAR;
#undef PG8_SA
#undef PG8_SB
#undef PG8_STAGE
#undef PG8_LDA
#undef PG8_LDB
#undef PG8_MMA
#undef PG8_WAIT_V
#undef PG8_WAIT_L
#undef PG8_BAR
#undef PG8_SCHED
}
}

#define XB_TMO      128
#define XB_XCNT(j)  (256  + 64 * (j))
#define XB_XSUB(j)  (1280 + 64 * (j))
#define XB_XGEN(j)  (2304 + 64 * (j))
#define XB_TOP      3328
#define XB_TOPGEN   3392
#define XCD_BAR_WORDS 3456
#define XB_SPIN_CAP (1u << 22)
__device__ __forceinline__ unsigned xb_ld(unsigned* p)              { return __hip_atomic_load(p, __ATOMIC_RELAXED, __HIP_MEMORY_SCOPE_AGENT); }
__device__ __forceinline__ unsigned xb_add(unsigned* p, unsigned v) { return __hip_atomic_fetch_add(p, v, __ATOMIC_RELAXED, __HIP_MEMORY_SCOPE_AGENT); }
__device__ __forceinline__ unsigned xb_xcc_id() { return (unsigned)__builtin_amdgcn_s_getreg((3 << 11) | 20) & 0xFu; }
#define XB_SPIN(cond, bar) do { unsigned _sp = 0; while (cond) { __builtin_amdgcn_s_sleep(1); \
    if ((++_sp & 255u) == 0u) { if (xb_ld(&(bar)[XB_TMO])) break; if (_sp > XB_SPIN_CAP) { atomicAdd(&(bar)[XB_TMO], 1u); break; } } } } while (0)
struct XcdBarrier { unsigned* bar; unsigned x; volatile LAS unsigned* st; };
__device__ __forceinline__ XcdBarrier xcd_barrier_post(unsigned* bar, volatile LAS unsigned* st) {
    XcdBarrier b; b.bar = bar; b.x = xb_xcc_id(); b.st = st;
    if (threadIdx.x == 0) (void)xb_add(&bar[XB_XCNT(b.x)], 1u);
    return b;
}
__device__ __forceinline__ void xcd_barrier_complete(unsigned* bar, unsigned x, unsigned& nloc, unsigned& nx) {
    const unsigned G = gridDim.x * gridDim.y * gridDim.z;
    unsigned sum, cnt, mine, sp = 0u;
    for (;;) {
        sum = 0u; cnt = 0u; mine = 0u;
#pragma unroll
        for (unsigned j = 0; j < 16; ++j) { const unsigned c = xb_ld(&bar[XB_XCNT(j)]); sum += c; cnt += (c > 0u) ? 1u : 0u; mine = (j == x) ? c : mine; }
        if (sum == G) break;
        __builtin_amdgcn_s_sleep(1);
        if ((++sp & 255u) == 0u) { if (xb_ld(&bar[XB_TMO])) break; if (sp > XB_SPIN_CAP) { atomicAdd(&bar[XB_TMO], 1u); break; } }
    }
    nloc = mine > 0u ? mine : 1u; nx = cnt > 0u ? cnt : 1u;
}
__device__ __forceinline__ void xcd_barrier(const XcdBarrier& b) {
    asm volatile("s_waitcnt vmcnt(0)" ::: "memory");
    __syncthreads();
    if (threadIdx.x == 0) {
        unsigned* bar = b.bar;
        __builtin_amdgcn_s_waitcnt(0);
        unsigned nloc = b.st[0], nx = b.st[1];
        if (nloc == 0u) { xcd_barrier_complete(bar, b.x, nloc, nx); b.st[0] = nloc; b.st[1] = nx; }
        const unsigned old = xb_add(&bar[XB_XSUB(b.x)], 1u);
        const unsigned gen = old / nloc;
        if (old + 1u == (gen + 1u) * nloc) {
            __builtin_amdgcn_fence(__ATOMIC_RELEASE, "agent");
            asm volatile("s_waitcnt vmcnt(0)" ::: "memory");
            const unsigned og = xb_add(&bar[XB_TOP], 1u);
            const unsigned tg = og / nx;
            if (og + 1u == (tg + 1u) * nx) xb_add(&bar[XB_TOPGEN], 1u);
            else XB_SPIN(xb_ld(&bar[XB_TOPGEN]) == tg, bar);
            __builtin_amdgcn_fence(__ATOMIC_ACQUIRE, "agent");
            xb_add(&bar[XB_XGEN(b.x)], 1u);
            asm volatile("s_waitcnt vmcnt(0)" ::: "memory");
        } else {
            XB_SPIN(xb_ld(&bar[XB_XGEN(b.x)]) == gen, bar);
            __builtin_amdgcn_fence(__ATOMIC_ACQUIRE, "agent");
            asm volatile("s_waitcnt vmcnt(0)" ::: "memory");
        }
    }
    __syncthreads();
}

struct Args { const float* in[21]; float* out; unsigned char* ws; int ph_lo, ph_hi; };
enum { I_X = 0, I_C, I_ADAW, I_ADAB, I_NPRE, I_NPOST, I_CWIN, I_CONVW, I_CWOUT, I_KVADAW, I_KVADAB, I_KVNORM, I_WKV, I_BKV, I_WQ, I_BQ, I_SINKS, I_WO, I_BO, I_UP, I_DOWN };

__device__ __forceinline__ float wave_sum(float v) {
#pragma unroll
    for (int o = 1; o < 64; o <<= 1) v += __shfl_xor(v, o);
    return v;
}

__device__ __forceinline__ void transpose_item(const float* W, int K, int N, bf16_t* WT, int item, int mode, LAS float* scr, int lane) {
    const int nblk = N / 32, kb = item / nblk, nb = item % nblk, k0 = 64 * kb, n0 = 32 * nb;
    const int n4 = (lane & 7) * 4;
#pragma unroll
    for (int i = 0; i < 8; ++i) { const int kk = i * 8 + (lane >> 3); const f32x4 v = *(const f32x4*)(W + (size_t)(k0 + kk) * N + n0 + n4);
        scr[kk * 33 + n4 + 0] = v[0]; scr[kk * 33 + n4 + 1] = v[1]; scr[kk * 33 + n4 + 2] = v[2]; scr[kk * 33 + n4 + 3] = v[3]; }
    asm volatile("s_waitcnt lgkmcnt(0)" ::: "memory");
    int drow0 = n0;
    if (mode == 1) { const int grp = n0 / DM, ch = n0 % DM; drow0 = (grp == 0) ? (4096 + ch) : ((ch >> 7) * 256 + (grp == 2 ? 128 : 0) + (ch & 127)); }
    const int c = lane & 7;
#pragma unroll
    for (int j = 0; j < 4; ++j) { const int n = (lane >> 3) + 8 * j; const LAS float* s = scr + (8 * c) * 33 + n;
        u32x4 o; o.x = cvtpk(s[0 * 33], s[1 * 33]); o.y = cvtpk(s[2 * 33], s[3 * 33]); o.z = cvtpk(s[4 * 33], s[5 * 33]); o.w = cvtpk(s[6 * 33], s[7 * 33]);
        *(u32x4*)(WT + (size_t)(drow0 + n) * K + k0 + 8 * c) = o; }
    asm volatile("s_waitcnt lgkmcnt(0)" ::: "memory");
}

__device__ __forceinline__ void gemv_item(const float* c_in, const float* ada_w, const float* kv_ada_w, float* modp, int item, int lane) {
    const int cgp = item % (NTOT / 256), kc = item / (NTOT / 256);
    const int ng = cgp * 256;
    const float* base; int ld, n;
    if (ng < 4 * 6144) { const int mat = ng / 6144; base = ada_w + (size_t)mat * DM * 6144; ld = 6144; n = ng - mat * 6144; }
    else { base = kv_ada_w; ld = 4096; n = ng - 4 * 6144; }
    float cv[4][4];
#pragma unroll
    for (int b = 0; b < 4; ++b)
#pragma unroll
        for (int j = 0; j < 4; ++j) { const float x = c_in[b * DM + kc * 256 + j * 64 + lane]; cv[b][j] = x / (1.f + __expf(-x)); }
    f32x4 acc[4];
#pragma unroll
    for (int b = 0; b < 4; ++b) acc[b] = (f32x4){0.f, 0.f, 0.f, 0.f};
    const float* wp = base + (size_t)(kc * 256) * ld + n + 4 * lane;
#pragma unroll
    for (int j = 0; j < 4; ++j) {
#pragma unroll 8
        for (int kk = 0; kk < 64; ++kk) {
            const f32x4 w = *(const f32x4*)(wp + (size_t)(j * 64 + kk) * ld);
#pragma unroll
            for (int b = 0; b < 4; ++b) { const float s = __int_as_float(__builtin_amdgcn_readlane(__float_as_int(cv[b][j]), kk)); acc[b] += w * s; }
        }
    }
#pragma unroll
    for (int b = 0; b < 4; ++b) *(f32x4*)(modp + (size_t)(kc * 4 + b) * NTOT + ng + 4 * lane) = acc[b];
}

__device__ __forceinline__ float mod_val(const float* modp, int b, int col, float bias) {
    float s = bias;
#pragma unroll
    for (int kc = 0; kc < KC; ++kc) s += modp[(size_t)(kc * 4 + b) * NTOT + col];
    return s;
}

template <bool HAS_Y, bool WRITE_X, bool OUT1, bool OUT2>
__device__ __forceinline__ void row_pass(unsigned char* lds, const Args& args, const bf16_t* Y, const float* xin, float* xout, int mat_gate, int mat_next, bf16_t* H1, bf16_t* H2) {
    float* gp = (float*)lds; float* ap = gp + DM; float* sp = ap + DM; float* akv = sp + DM; float* skv = akv + DM;
    const float* modp = (const float*)(args.ws + WS_MODP);
    const int tid = threadIdx.x, lane = tid & 63, wave = tid >> 6;
    const int bx = blockIdx.x, b = bx >> 6;
    __syncthreads();
    for (int d = tid; d < DM; d += 512) {
        if (HAS_Y) gp[d] = mod_val(modp, b, mat_gate * 6144 + 4096 + d, args.in[I_ADAB][mat_gate * 6144 + 4096 + d]) * args.in[I_NPOST][mat_gate * DM + d];
        if (OUT1) { ap[d] = (1.f + mod_val(modp, b, mat_next * 6144 + 2048 + d, args.in[I_ADAB][mat_next * 6144 + 2048 + d])) * args.in[I_NPRE][mat_next * DM + d];
                    sp[d] = mod_val(modp, b, mat_next * 6144 + d, args.in[I_ADAB][mat_next * 6144 + d]); }
        if (OUT2) { akv[d] = (1.f + mod_val(modp, b, 4 * 6144 + 2048 + d, args.in[I_KVADAB][2048 + d])) * args.in[I_KVNORM][d];
                    skv[d] = mod_val(modp, b, 4 * 6144 + d, args.in[I_KVADAB][d]); }
    }
    __syncthreads();
    for (int i = 0; i < 8; ++i) {
        const size_t row = (size_t)bx * 64 + wave * 8 + i;
        f32x4 xv[8];
#pragma unroll
        for (int j = 0; j < 8; ++j) xv[j] = *(const f32x4*)(xin + row * DM + 256 * j + 4 * lane);
        if (HAS_Y) {
            u32x2 yv[8]; float ss = 0.f;
#pragma unroll
            for (int j = 0; j < 8; ++j) { yv[j] = *(const u32x2*)(Y + row * DM + 256 * j + 4 * lane);
                const float a = bf_lo(yv[j].x), bq = bf_hi(yv[j].x), c = bf_lo(yv[j].y), d = bf_hi(yv[j].y); ss += (a * a + bq * bq) + (c * c + d * d); }
            const float rstd = __builtin_amdgcn_rsqf(wave_sum(ss) * (1.f / DM) + EPS);
#pragma unroll
            for (int j = 0; j < 8; ++j) { const f32x4 g = *(const f32x4*)(gp + 256 * j + 4 * lane);
                const f32x4 y = {bf_lo(yv[j].x), bf_hi(yv[j].x), bf_lo(yv[j].y), bf_hi(yv[j].y)};
                xv[j] = xv[j] + (y * rstd) * g; }
        }
        if (WRITE_X) {
#pragma unroll
            for (int j = 0; j < 8; ++j) *(f32x4*)(xout + row * DM + 256 * j + 4 * lane) = xv[j];
        }
        if (OUT1 || OUT2) {
            float ss = 0.f;
#pragma unroll
            for (int j = 0; j < 8; ++j) ss += (xv[j][0] * xv[j][0] + xv[j][1] * xv[j][1]) + (xv[j][2] * xv[j][2] + xv[j][3] * xv[j][3]);
            const float rstd = __builtin_amdgcn_rsqf(wave_sum(ss) * (1.f / DM) + EPS);
            if (OUT1) {
#pragma unroll
                for (int j = 0; j < 8; ++j) { const f32x4 a = *(const f32x4*)(ap + 256 * j + 4 * lane), s = *(const f32x4*)(sp + 256 * j + 4 * lane);
                    const f32x4 h = (xv[j] * rstd) * a + s; u32x2 w; w.x = cvtpk(h[0], h[1]); w.y = cvtpk(h[2], h[3]); *(u32x2*)(H1 + row * DM + 256 * j + 4 * lane) = w; }
            }
            if (OUT2) {
#pragma unroll
                for (int j = 0; j < 8; ++j) { const f32x4 a = *(const f32x4*)(akv + 256 * j + 4 * lane), s = *(const f32x4*)(skv + 256 * j + 4 * lane);
                    const f32x4 h = (xv[j] * rstd) * a + s; u32x2 w; w.x = cvtpk(h[0], h[1]); w.y = cvtpk(h[2], h[3]); *(u32x2*)(H2 + row * DM + 256 * j + 4 * lane) = w; }
            }
        }
    }
}

__device__ __forceinline__ void conv_pass(const bf16_t* Z, const bf16_t* Bg, const float* cw, bf16_t* Gout) {
    const int gt = blockIdx.x * 512 + threadIdx.x;
    const int ch = (gt & 255) * 8, run = gt >> 8;
    const size_t r0 = (size_t)run * 32; const int s0 = (int)(r0 & (SEQ - 1));
    float w0[8], w1[8], w2[8];
#pragma unroll
    for (int e = 0; e < 8; ++e) { w0[e] = cw[ch + e]; w1[e] = cw[DM + ch + e]; w2[e] = cw[2 * DM + ch + e]; }
    float zm2[8], zm1[8];
    if (s0 == 0) {
#pragma unroll
        for (int e = 0; e < 8; ++e) { zm2[e] = 0.f; zm1[e] = 0.f; }
    } else {
        const u32x4 a = *(const u32x4*)(Z + (r0 - 2) * DM + ch), bq = *(const u32x4*)(Z + (r0 - 1) * DM + ch);
#pragma unroll
        for (int e = 0; e < 4; ++e) { zm2[2 * e] = bf_lo(a[e]); zm2[2 * e + 1] = bf_hi(a[e]); zm1[2 * e] = bf_lo(bq[e]); zm1[2 * e + 1] = bf_hi(bq[e]); }
    }
#pragma unroll 4
    for (int i = 0; i < 32; ++i) {
        const u32x4 zz = *(const u32x4*)(Z + (r0 + i) * DM + ch), bb = *(const u32x4*)(Bg + (r0 + i) * DM + ch);
        float z[8], o[8];
#pragma unroll
        for (int e = 0; e < 4; ++e) { z[2 * e] = bf_lo(zz[e]); z[2 * e + 1] = bf_hi(zz[e]); }
#pragma unroll
        for (int e = 0; e < 4; ++e) { o[2 * e] = bf_lo(bb[e]) * (w0[2 * e] * zm2[2 * e] + w1[2 * e] * zm1[2 * e] + w2[2 * e] * z[2 * e]);
                                      o[2 * e + 1] = bf_hi(bb[e]) * (w0[2 * e + 1] * zm2[2 * e + 1] + w1[2 * e + 1] * zm1[2 * e + 1] + w2[2 * e + 1] * z[2 * e + 1]); }
        u32x4 w; w.x = cvtpk(o[0], o[1]); w.y = cvtpk(o[2], o[3]); w.z = cvtpk(o[4], o[5]); w.w = cvtpk(o[6], o[7]);
        *(u32x4*)(Gout + (r0 + i) * DM + ch) = w;
#pragma unroll
        for (int e = 0; e < 8; ++e) { zm2[e] = zm1[e]; zm1[e] = z[e]; }
    }
}

constexpr int KROW = 144, VROW = 528;
constexpr int ALDS_K = 0, ALDS_V = 256 * KROW;
__device__ __forceinline__ int crow(int r, int hi) { return (r & 3) + 8 * (r >> 2) + 4 * hi; }
__device__ __forceinline__ void attn_phase(unsigned char* lds, const bf16_t* Q, const bf16_t* Kg, const bf16_t* Vtg, bf16_t* O, const float* sinks) {
    const int tid = threadIdx.x, lane = tid & 63, wave = tid >> 6, r = lane & 31, hi = lane >> 5;
    for (int unit = blockIdx.x; unit < NBATCH * 32 * NKV; unit += gridDim.x) {
        const int b = unit >> 7, nb = (unit >> 2) & 31, kvh = unit & 3;
        __syncthreads();
#pragma unroll
        for (int i = 0; i < 4; ++i) { const int id = tid + 512 * i, row = id >> 3, ch = id & 7, pos = (nb - 1) * 128 + row;
            u32x4 v = {0u, 0u, 0u, 0u}; if (pos >= 0) v = *(const u32x4*)(Kg + (size_t)(b * SEQ + pos) * 256 + kvh * 64 + ch * 8);
            *(u32x4*)(lds + ALDS_K + row * KROW + ch * 16) = v; }
#pragma unroll
        for (int i = 0; i < 4; ++i) { const int id = tid + 512 * i, d = id >> 5, ch = id & 31, key0 = (nb - 1) * 128 + ch * 8;
            u32x4 v = {0u, 0u, 0u, 0u}; if (key0 >= 0) v = *(const u32x4*)(Vtg + ((size_t)(b * NKV + kvh) * HD + d) * SEQ + key0);
            *(u32x4*)(lds + ALDS_V + d * VROW + ch * 16) = v; }
        __syncthreads();
        const int head = kvh * 8 + wave;
        const float sink = sinks[head] * LOG2E;
        for (int qg = 0; qg < 4; ++qg) {
            const size_t row = (size_t)b * SEQ + nb * 128 + qg * 32 + r;
            bf16x8 qf[4];
#pragma unroll
            for (int s = 0; s < 4; ++s) qf[s] = *(const bf16x8*)(Q + row * DM + head * 64 + 16 * s + 8 * hi);
            f32x16 st[5];
#pragma unroll
            for (int kt = 0; kt < 5; ++kt) {
                f32x16 a;
#pragma unroll
                for (int e = 0; e < 16; ++e) a[e] = 0.f;
#pragma unroll
                for (int s = 0; s < 4; ++s) { const bf16x8 kf = *(const bf16x8*)(lds + ALDS_K + (32 * (qg + kt) + r) * KROW + (16 * s + 8 * hi) * 2);
                    a = __builtin_amdgcn_mfma_f32_32x32x16_bf16(kf, qf[s], a, 0, 0, 0); }
                st[kt] = a;
            }
            float mx = sink;
#pragma unroll
            for (int kt = 0; kt < 5; ++kt)
#pragma unroll
                for (int e = 0; e < 16; ++e) {
                    const int diff = 32 * kt + crow(e, hi) - r;
                    bool valid = true;
                    if (kt == 0) valid = diff >= 1;
                    if (kt == 4) valid = diff <= 128;
                    if (nb == 0 && (qg + kt) < 4) valid = false;
                    const float s = valid ? st[kt][e] : -INFINITY;
                    st[kt][e] = s; mx = fmaxf(mx, s);
                }
            mx = fmaxf(mx, __shfl_xor(mx, 32));
            float l = 0.f;
#pragma unroll
            for (int kt = 0; kt < 5; ++kt)
#pragma unroll
                for (int e = 0; e < 16; ++e) { const float p = __builtin_amdgcn_exp2f(st[kt][e] - mx); st[kt][e] = p; l += p; }
            l += __shfl_xor(l, 32);
            l += __builtin_amdgcn_exp2f(sink - mx);
            f32x16 o0, o1;
#pragma unroll
            for (int e = 0; e < 16; ++e) { o0[e] = 0.f; o1[e] = 0.f; }
#pragma unroll
            for (int kt = 0; kt < 5; ++kt)
#pragma unroll
                for (int s2 = 0; s2 < 2; ++s2) {
                    u32x4 pw; pw.x = cvtpk(st[kt][8 * s2 + 0], st[kt][8 * s2 + 1]); pw.y = cvtpk(st[kt][8 * s2 + 2], st[kt][8 * s2 + 3]);
                    pw.z = cvtpk(st[kt][8 * s2 + 4], st[kt][8 * s2 + 5]); pw.w = cvtpk(st[kt][8 * s2 + 6], st[kt][8 * s2 + 7]);
                    const bf16x8 pf = __builtin_bit_cast(bf16x8, pw);
                    const int kb = 32 * (qg + kt) + 16 * s2 + 4 * hi;
                    const s16x4 lo0 = *(const s16x4*)(lds + ALDS_V + r * VROW + kb * 2), hi0 = *(const s16x4*)(lds + ALDS_V + r * VROW + (kb + 8) * 2);
                    const s16x4 lo1 = *(const s16x4*)(lds + ALDS_V + (32 + r) * VROW + kb * 2), hi1 = *(const s16x4*)(lds + ALDS_V + (32 + r) * VROW + (kb + 8) * 2);
                    const bf16x8 v0 = __builtin_shufflevector(lo0, hi0, 0, 1, 2, 3, 4, 5, 6, 7), v1 = __builtin_shufflevector(lo1, hi1, 0, 1, 2, 3, 4, 5, 6, 7);
                    o0 = __builtin_amdgcn_mfma_f32_32x32x16_bf16(v0, pf, o0, 0, 0, 0);
                    o1 = __builtin_amdgcn_mfma_f32_32x32x16_bf16(v1, pf, o1, 0, 0, 0);
                }
            const float il = 1.f / l;
            bf16_t* op = O + row * DM + head * 64 + 4 * hi;
#pragma unroll
            for (int ig = 0; ig < 4; ++ig) {
                u32x2 w0, w1;
                w0.x = cvtpk(o0[4 * ig] * il, o0[4 * ig + 1] * il); w0.y = cvtpk(o0[4 * ig + 2] * il, o0[4 * ig + 3] * il);
                w1.x = cvtpk(o1[4 * ig] * il, o1[4 * ig + 1] * il); w1.y = cvtpk(o1[4 * ig + 2] * il, o1[4 * ig + 3] * il);
                *(u32x2*)(op + 8 * ig) = w0; *(u32x2*)(op + 32 + 8 * ig) = w1;
            }
        }
    }
}

__device__ __forceinline__ float rope_inv(int i) {
    return i == 0 ? 1.0f : i == 1 ? 0.1939227432012558f : i == 2 ? 0.03760603070259094f : i == 3 ? 0.007292664609849453f :
           i == 4 ? 0.0014142135623842478f : i == 5 ? 0.00027424818836152554f : i == 6 ? 5.3182957344688475e-05f : 1.0313385246263351e-05f;
}

__device__ __forceinline__ void prologue(unsigned char* lds, const Args& args) {
    const int tid = threadIdx.x, lane = tid & 63, wave = tid >> 6;
    const int G = gridDim.x, bx = blockIdx.x;
    const int vcu = (G % 8 == 0) ? (bx % 8) * (G / 8) + bx / 8 : bx;
    const int gw = vcu * NWAVES + wave, NGW = G * NWAVES;
    unsigned char* ws = args.ws;
    { const int id = bx * 512 + tid;
      if (id < SEQ * 8) { const int pos = id >> 3, i = id & 7; const float ang = (float)pos * rope_inv(i);
          const double rev = (double)ang * 0.15915494309189535; const float fr = (float)(rev - floor(rev));
          float* rp = (float*)(ws + WS_ROPE) + pos * 16; rp[i] = __builtin_amdgcn_cosf(fr); rp[8 + i] = __builtin_amdgcn_sinf(fr); } }
    for (int it = gw; it < (NTOT / 256) * KC; it += NGW) gemv_item(args.in[I_C], args.in[I_ADAW], args.in[I_KVADAW], (float*)(ws + WS_MODP), it, lane);
    LAS float* scr = (LAS float*)((LAS unsigned char*)lds + wave * 16384);
    constexpr int I_IN = 32 * 192, I_OUT = 32 * 64, I_UPI = 32 * 256, I_DN = 128 * 64, I_Q = 32 * 64, I_KV = 32 * 16, I_O = 32 * 64;
    constexpr int NITEMS = I_IN + I_OUT + 2 * I_UPI + 2 * I_DN + I_Q + I_KV + I_O;
    for (int it = gw; it < NITEMS; it += NGW) {
        int q = it;
        if (q < I_IN) { transpose_item(args.in[I_CWIN], DM, 3 * DM, (bf16_t*)(ws + WS_WIN), q, 1, scr, lane); continue; } q -= I_IN;
        if (q < I_OUT) { transpose_item(args.in[I_CWOUT], DM, DM, (bf16_t*)(ws + WS_WOUT), q, 0, scr, lane); continue; } q -= I_OUT;
        if (q < I_UPI) { transpose_item(args.in[I_UP], DM, DFF, (bf16_t*)(ws + WS_WUP0), q, 0, scr, lane); continue; } q -= I_UPI;
        if (q < I_UPI) { transpose_item(args.in[I_UP] + (size_t)DM * DFF, DM, DFF, (bf16_t*)(ws + WS_WUP1), q, 0, scr, lane); continue; } q -= I_UPI;
        if (q < I_DN) { transpose_item(args.in[I_DOWN], DFF, DM, (bf16_t*)(ws + WS_WDN0), q, 0, scr, lane); continue; } q -= I_DN;
        if (q < I_DN) { transpose_item(args.in[I_DOWN] + (size_t)DM * DFF, DFF, DM, (bf16_t*)(ws + WS_WDN1), q, 0, scr, lane); continue; } q -= I_DN;
        if (q < I_Q) { transpose_item(args.in[I_WQ], DM, DM, (bf16_t*)(ws + WS_WQ), q, 0, scr, lane); continue; } q -= I_Q;
        if (q < I_KV) { transpose_item(args.in[I_WKV], DM, 512, (bf16_t*)(ws + WS_WKV), q, 0, scr, lane); continue; } q -= I_KV;
        transpose_item(args.in[I_WO], DM, DM, (bf16_t*)(ws + WS_WO), q, 0, scr, lane);
    }
}

constexpr int N_PHASES = 16;
__global__ void __launch_bounds__(NWAVES * 64, 2) yoco_fwd(Args args) {
    extern __shared__ __attribute__((aligned(16))) unsigned char lds[];
#define G ((int)gridDim.x)
    const int lo = args.ph_lo, hi = args.ph_hi;
#define ldsg ((LAS unsigned char*)lds)
#if MK_XCD_BAR
    volatile LAS unsigned* misc = (volatile LAS unsigned*)(ldsg + 131072);
    if (threadIdx.x < 2) misc[threadIdx.x] = 0u;
    __syncthreads();
    (void)xcd_barrier_post((unsigned*)(args.ws + WS_CTL) + 1024, misc);
#define GRID_BAR(k) do { if ((k) == 0) cg::this_grid().sync(); else { XcdBarrier bar_; bar_.bar = (unsigned*)(args.ws + WS_CTL) + 1024; bar_.x = xb_xcc_id(); bar_.st = (volatile LAS unsigned*)((LAS unsigned char*)lds + 131072); xcd_barrier(bar_); } } while (0)
#else
#define GRID_BAR(k) cg::this_grid().sync()
#endif
#define IN(k) (lo <= (k) && (k) < hi)
#define SEAM(k) do { if (IN(k) && IN((k) + 1)) GRID_BAR(k); } while (0)
#define H ((bf16_t*)(args.ws + WS_H))
#define ZQ ((bf16_t*)(args.ws + WS_ZQ))
#define BO ((bf16_t*)(args.ws + WS_BO))
#define GK ((bf16_t*)(args.ws + WS_GK))
#define A ((bf16_t*)(args.ws + WS_A))
#define Kb ((bf16_t*)(args.ws + WS_K))
#define Vt ((bf16_t*)(args.ws + WS_VT))
#define rope ((const float*)(args.ws + WS_ROPE))
    pg8::StaticOrder S;

    if (IN(0)) { prologue(lds, args); } SEAM(0);
    if (IN(1)) { row_pass<false, false, true, false>(lds, args, nullptr, args.in[I_X], nullptr, 0, 0, H, nullptr); } SEAM(1);
    if (IN(2)) { pg8::Gemm g{H, (const bf16_t*)(args.ws + WS_WIN), T, 3 * DM, DM}; S.init(T, 3 * DM, G, (int)blockIdx.x); pg8::EpiZB E{ZQ, BO};
        pg8::gemm_phase<pg8::EpiZB, pg8::StaticOrder, true, true>(ldsg, g, S, E); } SEAM(2);
    if (IN(3)) { conv_pass(ZQ, BO, args.in[I_CONVW], GK); } SEAM(3);
    if (IN(4)) { pg8::Gemm g{GK, (const bf16_t*)(args.ws + WS_WOUT), T, DM, DM}; S.init(T, DM, G, (int)blockIdx.x); pg8::EpiBf16<0> E{H, DM, nullptr};
        pg8::gemm_phase<pg8::EpiBf16<0>, pg8::StaticOrder, true, true>(ldsg, g, S, E); } SEAM(4);
    if (IN(5)) { row_pass<true, true, true, false>(lds, args, H, args.in[I_X], args.out, 0, 1, H, nullptr); } SEAM(5);
    if (IN(6)) { pg8::Gemm g{H, (const bf16_t*)(args.ws + WS_WUP0), T, DFF, DM}; S.init(T, DFF, G, (int)blockIdx.x); pg8::EpiBf16<1> E{A, DFF, nullptr};
        pg8::gemm_phase<pg8::EpiBf16<1>, pg8::StaticOrder, true, true>(ldsg, g, S, E); } SEAM(6);
    if (IN(7)) { pg8::Gemm g{A, (const bf16_t*)(args.ws + WS_WDN0), T, DM, DFF}; S.init(T, DM, G, (int)blockIdx.x); pg8::EpiBf16<0> E{H, DM, nullptr};
        pg8::gemm_phase<pg8::EpiBf16<0>, pg8::StaticOrder, true, true>(ldsg, g, S, E); } SEAM(7);
    if (IN(8)) { row_pass<true, true, true, true>(lds, args, H, args.out, args.out, 1, 2, H, GK); } SEAM(8);
    if (IN(9)) {
        { pg8::Gemm g{H, (const bf16_t*)(args.ws + WS_WQ), T, DM, DM}; S.init(T, DM, G, (int)blockIdx.x); pg8::EpiQ E{ZQ, args.in[I_BQ], rope};
          pg8::gemm_phase<pg8::EpiQ, pg8::StaticOrder, true, true>(ldsg, g, S, E); }
        { pg8::Gemm g{GK, (const bf16_t*)(args.ws + WS_WKV), T, 512, DM}; S.init(T, 512, G, (int)blockIdx.x); pg8::EpiKV E{Kb, Vt, args.in[I_BKV], rope};
          pg8::gemm_phase<pg8::EpiKV, pg8::StaticOrder, true, true>(ldsg, g, S, E); }
    } SEAM(9);
    if (IN(10)) { attn_phase(lds, ZQ, Kb, Vt, BO, args.in[I_SINKS]); } SEAM(10);
    if (IN(11)) { pg8::Gemm g{BO, (const bf16_t*)(args.ws + WS_WO), T, DM, DM}; S.init(T, DM, G, (int)blockIdx.x); pg8::EpiBf16<0> E{H, DM, args.in[I_BO]};
        pg8::gemm_phase<pg8::EpiBf16<0>, pg8::StaticOrder, true, true>(ldsg, g, S, E); } SEAM(11);
    if (IN(12)) { row_pass<true, true, true, false>(lds, args, H, args.out, args.out, 2, 3, H, nullptr); } SEAM(12);
    if (IN(13)) { pg8::Gemm g{H, (const bf16_t*)(args.ws + WS_WUP1), T, DFF, DM}; S.init(T, DFF, G, (int)blockIdx.x); pg8::EpiBf16<1> E{A, DFF, nullptr};
        pg8::gemm_phase<pg8::EpiBf16<1>, pg8::StaticOrder, true, true>(ldsg, g, S, E); } SEAM(13);
    if (IN(14)) { pg8::Gemm g{A, (const bf16_t*)(args.ws + WS_WDN1), T, DM, DFF}; S.init(T, DM, G, (int)blockIdx.x); pg8::EpiBf16<0> E{H, DM, nullptr};
        pg8::gemm_phase<pg8::EpiBf16<0>, pg8::StaticOrder, true, true>(ldsg, g, S, E); } SEAM(14);
    if (IN(15)) { row_pass<true, true, false, false>(lds, args, H, args.out, args.out, 3, 0, nullptr, nullptr); }
#undef IN
#undef SEAM
#undef H
#undef ZQ
#undef BO
#undef GK
#undef A
#undef Kb
#undef Vt
#undef rope
#undef G
#undef ldsg
}

extern "C" void kernel_launch(void* const* d_in, const int* in_sizes, int n_in, void* d_out, int out_size, void* d_ws, size_t ws_size, hipStream_t stream) {
    static int grid = 0;
    if (grid == 0) {
        if (n_in != 21 || in_sizes[0] != T * DM || out_size != T * DM || ws_size < WS_END) { fprintf(stderr, "kernel_launch: unexpected shapes (n_in %d, in0 %d, out %d, ws %zu); nothing launched\n", n_in, n_in > 0 ? in_sizes[0] : -1, out_size, ws_size); grid = -1; return; }
        int dev = 0, cus = 0, per_cu = 0;
        if (hipGetDevice(&dev) != hipSuccess || hipDeviceGetAttribute(&cus, hipDeviceAttributeMultiprocessorCount, dev) != hipSuccess) { grid = -1; return; }
        if (hipFuncSetAttribute((const void*)yoco_fwd, hipFuncAttributeMaxDynamicSharedMemorySize, LDS_BYTES) != hipSuccess) { fprintf(stderr, "kernel_launch: hipFuncSetAttribute failed\n"); grid = -1; return; }
        if (hipOccupancyMaxActiveBlocksPerMultiprocessor(&per_cu, (const void*)yoco_fwd, NWAVES * 64, LDS_BYTES) != hipSuccess || per_cu < 1) { fprintf(stderr, "kernel_launch: occupancy query says %d\n", per_cu); per_cu = 1; }
        (void)hipGetLastError();
        grid = cus * 1;
        if (grid != 256) { fprintf(stderr, "kernel_launch: built for a 256-CU device, found %d CUs\n", cus); grid = -1; return; }
    }
    if (grid < 0) return;
    Args a{};
    for (int i = 0; i < 21; ++i) a.in[i] = (const float*)d_in[i];
    a.out = (float*)d_out; a.ws = (unsigned char*)d_ws;
    if (MK_N_LAUNCHES == 1) {
        (void)hipMemsetAsync((char*)d_ws + WS_CTL, 0, CTL_ZERO_BYTES, stream);
        a.ph_lo = 0; a.ph_hi = N_PHASES;
        void* kargs[] = {&a};
        hipError_t e = hipLaunchCooperativeKernel((const void*)yoco_fwd, dim3(grid), dim3(NWAVES * 64), kargs, LDS_BYTES, stream);
        if (e != hipSuccess) fprintf(stderr, "kernel_launch: cooperative launch failed: %s\n", hipGetErrorString(e));
    } else {
        for (int p = 0; p < N_PHASES; ++p) { a.ph_lo = p; a.ph_hi = p + 1; hipLaunchKernelGGL(yoco_fwd, dim3(grid), dim3(NWAVES * 64), LDS_BYTES, stream, a); }
    }
}
```

```cpp
#include <hip/hip_runtime.h>
#include <hip/hip_cooperative_groups.h>
#include <cstdio>
#include <cstdint>
#include <cmath>
namespace cg = cooperative_groups;

#ifndef MK_N_LAUNCHES
#define MK_N_LAUNCHES 1
#endif
#ifndef MK_XCD_BAR
#define MK_XCD_BAR 1
#endif

#ifndef PG8_ALIGN
#define PG8_ALIGN true
#endif
#ifndef PG8_SP2
#define PG8_SP2 true
#endif
#ifndef PROBE_MASK
#define PROBE_MASK 0
#endif
#define LAS __attribute__((address_space(3)))
typedef unsigned short bf16_t;
typedef short bf16x8 __attribute__((ext_vector_type(8)));
typedef short s16x4 __attribute__((ext_vector_type(4)));
typedef float f32x4 __attribute__((ext_vector_type(4)));
typedef float f32x16 __attribute__((ext_vector_type(16)));
typedef unsigned u32x4 __attribute__((ext_vector_type(4)));
typedef unsigned u32x2 __attribute__((ext_vector_type(2)));
typedef float f32x2_t __attribute__((ext_vector_type(2)));
typedef __bf16 bf16x2_t __attribute__((ext_vector_type(2)));

constexpr int DM = 2048, NBATCH = 4, SEQ = 4096, T = NBATCH * SEQ, DFF = 8192, NH = 32, NKV = 4, HD = 64;
constexpr int NTOT = 4 * 6144 + 4096;
constexpr int KC = 8;
constexpr float EPS = 1e-6f;
constexpr float LOG2E = 1.4426950408889634f;
constexpr float QSCALE = 0.125f * LOG2E;

constexpr size_t MiB = 1u << 20;
constexpr size_t WS_CTL = 0, CTL_ZERO_BYTES = 64 * 1024;
constexpr size_t WS_MODP = 1 * MiB;
constexpr size_t WS_ROPE = 5 * MiB;
constexpr size_t WS_WIN = 8 * MiB, WS_WOUT = 32 * MiB, WS_WUP0 = 40 * MiB, WS_WUP1 = 72 * MiB, WS_WDN0 = 104 * MiB, WS_WDN1 = 136 * MiB;
constexpr size_t WS_WQ = 168 * MiB, WS_WKV = 176 * MiB, WS_WO = 178 * MiB;
constexpr size_t WS_H = 192 * MiB;
constexpr size_t WS_ZQ = 256 * MiB;
constexpr size_t WS_BO = 320 * MiB;
constexpr size_t WS_GK = 384 * MiB;
constexpr size_t WS_A = 448 * MiB;
constexpr size_t WS_K = 704 * MiB;
constexpr size_t WS_VT = 712 * MiB;
constexpr size_t WS_END = 720 * MiB;

constexpr int LDS_BYTES = 147456;
constexpr int NWAVES = 8;

__device__ __forceinline__ unsigned cvtpk(float lo, float hi) { f32x2_t v = {lo, hi}; bf16x2_t b = __builtin_convertvector(v, bf16x2_t); return __builtin_bit_cast(unsigned, b); }
__device__ __forceinline__ float bf_lo(unsigned u) { return __uint_as_float(u << 16); }
__device__ __forceinline__ float bf_hi(unsigned u) { return __uint_as_float(u & 0xffff0000u); }
__device__ __forceinline__ void st8(bf16_t* p, f32x4 v0, f32x4 v1) { u32x4 w; w.x = cvtpk(v0[0], v0[1]); w.y = cvtpk(v0[2], v0[3]); w.z = cvtpk(v1[0], v1[1]); w.w = cvtpk(v1[2], v1[3]); *(u32x4*)p = w; }

namespace pg8 {
#define PG8_LAS __attribute__((address_space(3)))
constexpr int BM = 256, BK = 64, HALF = 128, HTB = HALF * BK * 2, STAGE_BYTES = 8 * HTB, NXCD = 8, WGM = 8;
__host__ __device__ __forceinline__ int lds_byte(int r, int c) { const int st = (r >> 4) * 2 + (c >> 5), rr = r & 15, cc = c & 31, ob = rr * 64 + cc * 2; return st * 1024 + (ob ^ (((ob >> 9) & 1) << 5)); }
__host__ __device__ __forceinline__ void stage_rc(int b, int& R, int& C) { const int st = b / 1024, sb = b % 1024, swz = sb ^ (((sb >> 9) & 1) << 5); R = (st >> 1) * 16 + swz / 64; C = (st & 1) * 32 + (swz % 64) / 2; }
__host__ __device__ __forceinline__ int perm32(int rho) { const int n = rho >> 4, i = rho & 15; return 8 * (i >> 2) + 4 * n + (i & 3); }

struct Unit { int pm, pn; };
struct Gemm { const bf16_t* A; const bf16_t* Bt; int M, N, K; };
struct StaticOrder {
    int nM, nN, nwg, G, c;
    __host__ __device__ void init(int M, int N, int G_, int c_) { nM = M / BM; nN = N / BM; nwg = nM * nN; G = G_; c = c_; }
    __host__ __device__ bool next(int i, Unit& u) const {
        const long L = (long)i * G + c; if (L >= nwg) return false;
        int wgid = (int)L; { const int q = nwg / NXCD, r = nwg % NXCD, xcd = wgid % NXCD, off = wgid / NXCD; wgid = (xcd < r ? xcd * (q + 1) : r * (q + 1) + (xcd - r) * q) + off; }
        const int nig = WGM * nN, gid = wgid / nig, fm = gid * WGM, gsz = (nM - fm) < WGM ? (nM - fm) : WGM;
        u.pm = fm + ((wgid % nig) % gsz); u.pn = (wgid % nig) / gsz; return true;
    }
};


template <int ACT> struct EpiBf16 {
    bf16_t* O; int ldc; const float* bias;
    __device__ __forceinline__ void operator()(const f32x4 (&acc)[2][2][4][2], const Unit& u, int wr, int wc, int fr, int fq) const {
        const int row0 = u.pm * BM + wr * 64 + fr, col0 = u.pn * BM + wc * 32 + 8 * fq;
        f32x4 bv[2][2];
#pragma unroll
        for (int bj = 0; bj < 2; ++bj)
#pragma unroll
            for (int n = 0; n < 2; ++n) bv[bj][n] = bias ? *(const f32x4*)(bias + col0 + bj * HALF + 4 * n) : (f32x4){0.f, 0.f, 0.f, 0.f};
#pragma unroll
        for (int ai = 0; ai < 2; ++ai)
#pragma unroll
            for (int m = 0; m < 4; ++m) { bf16_t* rowp = O + (size_t)(row0 + ai * HALF + m * 16) * ldc + col0;
#pragma unroll
                for (int bj = 0; bj < 2; ++bj) { f32x4 v0 = acc[ai][bj][m][0] + bv[bj][0], v1 = acc[ai][bj][m][1] + bv[bj][1];
                    if (ACT == 1) { v0 = __builtin_elementwise_max(v0, (f32x4){0.f, 0.f, 0.f, 0.f}); v1 = __builtin_elementwise_max(v1, (f32x4){0.f, 0.f, 0.f, 0.f}); v0 = v0 * v0; v1 = v1 * v1; }
                    st8(rowp + bj * HALF, v0, v1); } }
    }
};
struct EpiZB {
    bf16_t* Z; bf16_t* Bg;
    __device__ __forceinline__ void operator()(const f32x4 (&acc)[2][2][4][2], const Unit& u, int wr, int wc, int fr, int fq) const {
        const int row0 = u.pm * BM + wr * 64 + fr;
        if (u.pn < 16) {
            const int col0 = u.pn * HALF + wc * 32 + 8 * fq;
#pragma unroll
            for (int ai = 0; ai < 2; ++ai)
#pragma unroll
                for (int m = 0; m < 4; ++m) st8(Z + (size_t)(row0 + ai * HALF + m * 16) * DM + col0, acc[ai][0][m][0] * acc[ai][1][m][0], acc[ai][0][m][1] * acc[ai][1][m][1]);
        } else {
            const int col0 = (u.pn - 16) * BM + wc * 32 + 8 * fq;
#pragma unroll
            for (int ai = 0; ai < 2; ++ai)
#pragma unroll
                for (int m = 0; m < 4; ++m)
#pragma unroll
                    for (int bj = 0; bj < 2; ++bj) st8(Bg + (size_t)(row0 + ai * HALF + m * 16) * DM + col0 + bj * HALF, acc[ai][bj][m][0], acc[ai][bj][m][1]);
        }
    }
};
__device__ __forceinline__ void rope8(f32x4& v0, f32x4& v1, const float* rope, int pos, int fq) {
    f32x4 p0, p1;
#pragma unroll
    for (int e = 0; e < 4; ++e) { p0[e] = __shfl_xor(v0[e], 16); p1[e] = __shfl_xor(v1[e], 16); }
    if (fq < 2) {
        const float* rp = rope + (size_t)pos * 16;
        const f32x4 c0 = *(const f32x4*)(rp), c1 = *(const f32x4*)(rp + 4), s0 = *(const f32x4*)(rp + 8), s1 = *(const f32x4*)(rp + 12);
        if (fq == 0) { v0 = v0 * c0 - p0 * s0; v1 = v1 * c1 - p1 * s1; }
        else         { v0 = v0 * c0 + p0 * s0; v1 = v1 * c1 + p1 * s1; }
    }
}
struct EpiQ {
    bf16_t* O; const float* bias; const float* rope;
    __device__ __forceinline__ void operator()(const f32x4 (&acc)[2][2][4][2], const Unit& u, int wr, int wc, int fr, int fq) const {
        const int row0 = u.pm * BM + wr * 64 + fr, col0 = u.pn * BM + wc * 32 + 8 * fq;
#pragma unroll
        for (int ai = 0; ai < 2; ++ai)
#pragma unroll
            for (int m = 0; m < 4; ++m) { const int row = row0 + ai * HALF + m * 16;
#pragma unroll
                for (int bj = 0; bj < 2; ++bj) {
                    f32x4 v0 = acc[ai][bj][m][0] + *(const f32x4*)(bias + col0 + bj * HALF), v1 = acc[ai][bj][m][1] + *(const f32x4*)(bias + col0 + bj * HALF + 4);
                    if ((wc & 1) == 0) rope8(v0, v1, rope, row & (SEQ - 1), fq);
                    st8(O + (size_t)row * DM + col0 + bj * HALF, v0 * QSCALE, v1 * QSCALE); } }
    }
};
struct EpiKV {
    bf16_t* Kb; bf16_t* Vt; const float* bias; const float* rope;
    __device__ __forceinline__ void operator()(const f32x4 (&acc)[2][2][4][2], const Unit& u, int wr, int wc, int fr, int fq) const {
        const int row0 = u.pm * BM + wr * 64 + fr, colt = wc * 32 + 8 * fq;
#pragma unroll
        for (int ai = 0; ai < 2; ++ai)
#pragma unroll
            for (int m = 0; m < 4; ++m) { const int row = row0 + ai * HALF + m * 16, pos = row & (SEQ - 1), b = row / SEQ;
#pragma unroll
                for (int bj = 0; bj < 2; ++bj) { const int col = colt + bj * HALF;
                    f32x4 v0 = acc[ai][bj][m][0] + *(const f32x4*)(bias + u.pn * BM + col), v1 = acc[ai][bj][m][1] + *(const f32x4*)(bias + u.pn * BM + col + 4);
                    if (u.pn == 0) { if ((wc & 1) == 0) rope8(v0, v1, rope, pos, fq); st8(Kb + (size_t)row * 256 + col, v0, v1); }
                    else { const int kvh = col >> 6, d = col & 63; bf16_t* vp = Vt + ((size_t)(b * NKV + kvh) * HD + d) * SEQ + pos;
#pragma unroll
                        for (int e = 0; e < 4; ++e) { vp[(size_t)e * SEQ] = (bf16_t)(cvtpk(v0[e], 0.f) & 0xffffu); vp[(size_t)(e + 4) * SEQ] = (bf16_t)(cvtpk(v1[e], 0.f) & 0xffffu); } } } }
    }
};

template <class Epi, class Sched, bool ALIGN_EPI = false, bool SP2 = false>
__device__ __forceinline__ void gemm_phase(PG8_LAS unsigned char* lds, const Gemm g, const Sched& S, const Epi& E) {
    const int tid = threadIdx.x, wid = __builtin_amdgcn_readfirstlane(tid >> 6), lane = tid & 63, wr = wid >> 2, wc = wid & 3, fr = lane & 15, fq = lane >> 4;
    const int K = g.K, nt = K / BK;
    unsigned voffA[2], voffB[2];
#pragma unroll
    for (int i = 0; i < 2; ++i) { int R, C; stage_rc(tid * 16 + i * 8192, R, C); const int Rb = (R & ~31) + perm32(R & 31);
        voffA[i] = (unsigned)(R * K + C) * 2u; voffB[i] = (unsigned)(Rb * K + C) * 2u; }
    const size_t kstep = (size_t)(BK * 2);
    const size_t hstep = (size_t)HALF * K * 2;
    const size_t tstep = 2 * hstep;
    const unsigned ldsw = (unsigned)wid * 1024u;
    const int aoff = lds_byte(wr * 64 + fr, fq * 8), boff = lds_byte(wc * 32 + fr, fq * 8);
#define PG8_SA(b, h) (((b) * 2 + (h)) * HTB)
#define PG8_SB(b, h) ((4 + (b) * 2 + (h)) * HTB)
#define PG8_STAGE(bufoff, gbase, voff) do { _Pragma("unroll") for (int _i = 0; _i < 2; ++_i) \
        __builtin_amdgcn_global_load_lds((const unsigned*)((const char*)(gbase) + (voff)[_i]), (PG8_LAS unsigned*)(lds + (bufoff) + ldsw + _i * 8192), 16, 0, 0); } while (0)
#define PG8_LDA(dst, b, h) do { _Pragma("unroll") for (int m = 0; m < 4; ++m) _Pragma("unroll") for (int k = 0; k < 2; ++k) dst[m][k] = *(const PG8_LAS bf16x8*)(lds + PG8_SA(b, h) + aoff + m * 2048 + k * 1024); } while (0)
#define PG8_LDB(dst, b, h) do { _Pragma("unroll") for (int n = 0; n < 2; ++n) _Pragma("unroll") for (int k = 0; k < 2; ++k) dst[n][k] = *(const PG8_LAS bf16x8*)(lds + PG8_SB(b, h) + boff + n * 2048 + k * 1024); } while (0)
#define PG8_MMA(ai, bj, At, Bt) do { __builtin_amdgcn_s_setprio(1); _Pragma("unroll") for (int m = 0; m < 4; ++m) _Pragma("unroll") for (int n = 0; n < 2; ++n) _Pragma("unroll") for (int k = 0; k < 2; ++k) \
        acc[ai][bj][m][n] = __builtin_amdgcn_mfma_f32_16x16x32_bf16(Bt[n][k], At[m][k], acc[ai][bj][m][n], 0, 0, 0); __builtin_amdgcn_s_setprio(0); } while (0)
#define PG8_WAIT_V(n) asm volatile("s_waitcnt vmcnt(" #n ")" ::: "memory")
#define PG8_WAIT_L(n) asm volatile("s_waitcnt lgkmcnt(" #n ")" ::: "memory")
#define PG8_BAR __builtin_amdgcn_s_barrier()
#define PG8_SCHED __builtin_amdgcn_sched_barrier(0)
    Unit cur, nxt; int ui = 0;
    if (!S.next(0, cur)) return;
    f32x4 acc[2][2][4][2];
#pragma unroll
    for (int a = 0; a < 2; ++a)
#pragma unroll
        for (int b = 0; b < 2; ++b)
#pragma unroll
            for (int m = 0; m < 4; ++m)
#pragma unroll
                for (int n = 0; n < 2; ++n) acc[a][b][m][n] = (f32x4){0.f, 0.f, 0.f, 0.f};
    bf16x8 At[4][2], B0[2][2], B1[2][2];
    const char* cA = (const char*)g.A + (size_t)cur.pm * tstep; const char* cB = (const char*)g.Bt + (size_t)cur.pn * tstep;
    if constexpr (SP2) {
        PG8_STAGE(PG8_SB(0, 0), cB, voffB); PG8_STAGE(PG8_SB(0, 1), cB + hstep, voffB); PG8_STAGE(PG8_SA(0, 0), cA, voffA); PG8_STAGE(PG8_SA(0, 1), cA + hstep, voffA);
        if (wr == 1) PG8_BAR;
        PG8_WAIT_V(2); PG8_BAR;
        PG8_STAGE(PG8_SB(1, 0), cB + kstep, voffB); PG8_STAGE(PG8_SA(1, 0), cA + kstep, voffA); PG8_STAGE(PG8_SB(1, 1), cB + hstep + kstep, voffB);
        PG8_WAIT_V(6); PG8_BAR;
    } else {
        PG8_STAGE(PG8_SB(0, 0), cB, voffB); PG8_STAGE(PG8_SA(0, 0), cA, voffA); PG8_STAGE(PG8_SB(0, 1), cB + hstep, voffB); PG8_STAGE(PG8_SA(0, 1), cA + hstep, voffA);
        if (wr == 1) PG8_BAR;
        PG8_WAIT_V(4); PG8_BAR;
        PG8_STAGE(PG8_SB(1, 0), cB + kstep, voffB); PG8_STAGE(PG8_SA(1, 0), cA + kstep, voffA); PG8_STAGE(PG8_SB(1, 1), cB + hstep + kstep, voffB);
        PG8_WAIT_V(6); PG8_BAR;
    }
    for (;;) {
        const bool has_next = S.next(ui + 1, nxt);
        const char* nA = has_next ? (const char*)g.A + (size_t)nxt.pm * tstep : cA; const char* nB = has_next ? (const char*)g.Bt + (size_t)nxt.pn * tstep : cB;
        for (int t = 0; t < nt; t += 2) {
            const bool last = (t == nt - 2);
            const char* a1 = cA + (size_t)(t + 1) * kstep;
            const char* a2 = last ? nA : cA + (size_t)(t + 2) * kstep; const char* b2 = last ? nB : cB + (size_t)(t + 2) * kstep;
            const char* a3 = a2 + kstep; const char* b3 = b2 + kstep;
            if constexpr (SP2) {
            PG8_LDB(B0, 0, 0); PG8_LDB(B1, 0, 1); PG8_SCHED; PG8_LDA(At, 0, 0); PG8_STAGE(PG8_SA(1, 1), a1 + hstep, voffA);
            PG8_WAIT_V(8); PG8_WAIT_L(0); PG8_BAR; PG8_MMA(0, 0, At, B0); PG8_MMA(0, 1, At, B1); PG8_BAR; PG8_SCHED;
            PG8_LDA(At, 0, 1); PG8_STAGE(PG8_SB(0, 0), b2, voffB); PG8_STAGE(PG8_SB(0, 1), b2 + hstep, voffB); PG8_STAGE(PG8_SA(0, 0), a2, voffA);
            PG8_WAIT_V(8); PG8_WAIT_L(0); PG8_BAR; PG8_MMA(1, 0, At, B0); PG8_MMA(1, 1, At, B1); PG8_BAR; PG8_SCHED;
            PG8_LDB(B0, 1, 0); PG8_LDB(B1, 1, 1); PG8_SCHED; PG8_LDA(At, 1, 0); PG8_STAGE(PG8_SA(0, 1), a2 + hstep, voffA);
            PG8_WAIT_V(8); PG8_WAIT_L(0); PG8_BAR; PG8_MMA(0, 0, At, B0); PG8_MMA(0, 1, At, B1); PG8_BAR; PG8_SCHED;
            PG8_LDA(At, 1, 1); PG8_STAGE(PG8_SB(1, 0), b3, voffB); PG8_STAGE(PG8_SB(1, 1), b3 + hstep, voffB); PG8_STAGE(PG8_SA(1, 0), a3, voffA);
            PG8_WAIT_V(8); PG8_WAIT_L(0); PG8_BAR; PG8_MMA(1, 0, At, B0); PG8_MMA(1, 1, At, B1); PG8_BAR; PG8_SCHED;
            } else {
            PG8_LDB(B0, 0, 0); PG8_SCHED; PG8_LDA(At, 0, 0); PG8_STAGE(PG8_SA(1, 1), a1 + hstep, voffA);
            PG8_WAIT_L(8); PG8_BAR; PG8_WAIT_L(0); PG8_MMA(0, 0, At, B0); PG8_BAR; PG8_SCHED;
            PG8_LDB(B1, 0, 1); PG8_STAGE(PG8_SB(0, 0), b2, voffB);
            PG8_BAR; PG8_WAIT_L(0); PG8_MMA(0, 1, At, B1); PG8_BAR;
            PG8_LDA(At, 0, 1); PG8_STAGE(PG8_SA(0, 0), a2, voffA);
            PG8_BAR; PG8_WAIT_L(0); PG8_MMA(1, 0, At, B0); PG8_BAR; PG8_SCHED;
            PG8_STAGE(PG8_SB(0, 1), b2 + hstep, voffB);
            PG8_WAIT_V(6); PG8_BAR; PG8_MMA(1, 1, At, B1); PG8_BAR;
            PG8_LDB(B0, 1, 0); PG8_SCHED; PG8_LDA(At, 1, 0); PG8_STAGE(PG8_SA(0, 1), a2 + hstep, voffA);
            PG8_WAIT_L(8); PG8_BAR; PG8_WAIT_L(0); PG8_MMA(0, 0, At, B0); PG8_BAR; PG8_SCHED;
            PG8_LDB(B1, 1, 1); PG8_STAGE(PG8_SB(1, 0), b3, voffB);
            PG8_BAR; PG8_WAIT_L(0); PG8_MMA(0, 1, At, B1); PG8_BAR;
            PG8_LDA(At, 1, 1); PG8_STAGE(PG8_SA(1, 0), a3, voffA);
            PG8_BAR; PG8_WAIT_L(0); PG8_MMA(1, 0, At, B0); PG8_BAR; PG8_SCHED;
            PG8_STAGE(PG8_SB(1, 1), b3 + hstep, voffB);
            PG8_WAIT_V(6); PG8_BAR; PG8_MMA(1, 1, At, B1); PG8_BAR;
            }
        }
        if constexpr (ALIGN_EPI) { if (wr == 0) PG8_BAR; }
        E(acc, cur, wr, wc, fr, fq);
        if (!has_next) break;
#pragma unroll
        for (int a = 0; a < 2; ++a)
#pragma unroll
            for (int b = 0; b < 2; ++b)
#pragma unroll
                for (int m = 0; m < 4; ++m)
#pragma unroll
                    for (int n = 0; n < 2; ++n) acc[a][b][m][n] = (f32x4){0.f, 0.f, 0.f, 0.f};
        cur = nxt; cA = nA; cB = nB; ++ui;
        if constexpr (ALIGN_EPI) { if (wr == 1) PG8_BAR; }
    }
    PG8_WAIT_V(0);
    if constexpr (!ALIGN_EPI) { if (wr == 0) PG8_BAR; }
    PG8_BAR;
#undef PG8_SA
#undef PG8_SB
#undef PG8_STAGE
#undef PG8_LDA
#undef PG8_LDB
#undef PG8_MMA
#undef PG8_WAIT_V
#undef PG8_WAIT_L
#undef PG8_BAR
#undef PG8_SCHED
}
}

#define XB_TMO      128
#define XB_XCNT(j)  (256  + 64 * (j))
#define XB_XSUB(j)  (1280 + 64 * (j))
#define XB_XGEN(j)  (2304 + 64 * (j))
#define XB_TOP      3328
#define XB_TOPGEN   3392
#define XCD_BAR_WORDS 3456
#define XB_SPIN_CAP (1u << 22)
__device__ __forceinline__ unsigned xb_ld(unsigned* p)              { return __hip_atomic_load(p, __ATOMIC_RELAXED, __HIP_MEMORY_SCOPE_AGENT); }
__device__ __forceinline__ unsigned xb_add(unsigned* p, unsigned v) { return __hip_atomic_fetch_add(p, v, __ATOMIC_RELAXED, __HIP_MEMORY_SCOPE_AGENT); }
__device__ __forceinline__ unsigned xb_xcc_id() { return (unsigned)__builtin_amdgcn_s_getreg((3 << 11) | 20) & 0xFu; }
#define XB_SPIN(cond, bar) do { unsigned _sp = 0; while (cond) { __builtin_amdgcn_s_sleep(1); \
    if ((++_sp & 255u) == 0u) { if (xb_ld(&(bar)[XB_TMO])) break; if (_sp > XB_SPIN_CAP) { atomicAdd(&(bar)[XB_TMO], 1u); break; } } } } while (0)
struct XcdBarrier { unsigned* bar; unsigned x; volatile LAS unsigned* st; };
__device__ __forceinline__ XcdBarrier xcd_barrier_post(unsigned* bar, volatile LAS unsigned* st) {
    XcdBarrier b; b.bar = bar; b.x = xb_xcc_id(); b.st = st;
    if (threadIdx.x == 0) (void)xb_add(&bar[XB_XCNT(b.x)], 1u);
    return b;
}
__device__ __forceinline__ void xcd_barrier_complete(unsigned* bar, unsigned x, unsigned& nloc, unsigned& nx) {
    const unsigned G = gridDim.x * gridDim.y * gridDim.z;
    unsigned sum, cnt, mine, sp = 0u;
    for (;;) {
        sum = 0u; cnt = 0u; mine = 0u;
#pragma unroll
        for (unsigned j = 0; j < 16; ++j) { const unsigned c = xb_ld(&bar[XB_XCNT(j)]); sum += c; cnt += (c > 0u) ? 1u : 0u; mine = (j == x) ? c : mine; }
        if (sum == G) break;
        __builtin_amdgcn_s_sleep(1);
        if ((++sp & 255u) == 0u) { if (xb_ld(&bar[XB_TMO])) break; if (sp > XB_SPIN_CAP) { atomicAdd(&bar[XB_TMO], 1u); break; } }
    }
    nloc = mine > 0u ? mine : 1u; nx = cnt > 0u ? cnt : 1u;
}
__device__ __forceinline__ void xcd_barrier(const XcdBarrier& b) {
    asm volatile("s_waitcnt vmcnt(0)" ::: "memory");
    __syncthreads();
    if (threadIdx.x == 0) {
        unsigned* bar = b.bar;
        __builtin_amdgcn_s_waitcnt(0);
        unsigned nloc = b.st[0], nx = b.st[1];
        if (nloc == 0u) { xcd_barrier_complete(bar, b.x, nloc, nx); b.st[0] = nloc; b.st[1] = nx; }
        const unsigned old = xb_add(&bar[XB_XSUB(b.x)], 1u);
        const unsigned gen = old / nloc;
        if (old + 1u == (gen + 1u) * nloc) {
            __builtin_amdgcn_fence(__ATOMIC_RELEASE, "agent");
            asm volatile("s_waitcnt vmcnt(0)" ::: "memory");
            const unsigned og = xb_add(&bar[XB_TOP], 1u);
            const unsigned tg = og / nx;
            if (og + 1u == (tg + 1u) * nx) xb_add(&bar[XB_TOPGEN], 1u);
            else XB_SPIN(xb_ld(&bar[XB_TOPGEN]) == tg, bar);
            __builtin_amdgcn_fence(__ATOMIC_ACQUIRE, "agent");
            xb_add(&bar[XB_XGEN(b.x)], 1u);
            asm volatile("s_waitcnt vmcnt(0)" ::: "memory");
        } else {
            XB_SPIN(xb_ld(&bar[XB_XGEN(b.x)]) == gen, bar);
            __builtin_amdgcn_fence(__ATOMIC_ACQUIRE, "agent");
            asm volatile("s_waitcnt vmcnt(0)" ::: "memory");
        }
    }
    __syncthreads();
}

struct Args { const float* in[21]; float* out; unsigned char* ws; int ph_lo, ph_hi; };
enum { I_X = 0, I_C, I_ADAW, I_ADAB, I_NPRE, I_NPOST, I_CWIN, I_CONVW, I_CWOUT, I_KVADAW, I_KVADAB, I_KVNORM, I_WKV, I_BKV, I_WQ, I_BQ, I_SINKS, I_WO, I_BO, I_UP, I_DOWN };

__device__ __forceinline__ float wave_sum(float v) {
#pragma unroll
    for (int o = 1; o < 64; o <<= 1) v += __shfl_xor(v, o);
    return v;
}

__device__ __forceinline__ void transpose_item(const float* W, int K, int N, bf16_t* WT, int item, int mode, LAS float* scr, int lane) {
    const int nblk = N / 32, kb = item / nblk, nb = item % nblk, k0 = 64 * kb, n0 = 32 * nb;
    const int n4 = (lane & 7) * 4;
#pragma unroll
    for (int i = 0; i < 8; ++i) { const int kk = i * 8 + (lane >> 3); const f32x4 v = *(const f32x4*)(W + (size_t)(k0 + kk) * N + n0 + n4);
        scr[kk * 33 + n4 + 0] = v[0]; scr[kk * 33 + n4 + 1] = v[1]; scr[kk * 33 + n4 + 2] = v[2]; scr[kk * 33 + n4 + 3] = v[3]; }
    asm volatile("s_waitcnt lgkmcnt(0)" ::: "memory");
    int drow0 = n0;
    if (mode == 1) { const int grp = n0 / DM, ch = n0 % DM; drow0 = (grp == 0) ? (4096 + ch) : ((ch >> 7) * 256 + (grp == 2 ? 128 : 0) + (ch & 127)); }
    const int c = lane & 7;
#pragma unroll
    for (int j = 0; j < 4; ++j) { const int n = (lane >> 3) + 8 * j; const LAS float* s = scr + (8 * c) * 33 + n;
        u32x4 o; o.x = cvtpk(s[0 * 33], s[1 * 33]); o.y = cvtpk(s[2 * 33], s[3 * 33]); o.z = cvtpk(s[4 * 33], s[5 * 33]); o.w = cvtpk(s[6 * 33], s[7 * 33]);
        *(u32x4*)(WT + (size_t)(drow0 + n) * K + k0 + 8 * c) = o; }
    asm volatile("s_waitcnt lgkmcnt(0)" ::: "memory");
}

__device__ __forceinline__ void gemv_item(const float* c_in, const float* ada_w, const float* kv_ada_w, float* modp, int item, int lane) {
    const int cgp = item % (NTOT / 256), kc = item / (NTOT / 256);
    const int ng = cgp * 256;
    const float* base; int ld, n;
    if (ng < 4 * 6144) { const int mat = ng / 6144; base = ada_w + (size_t)mat * DM * 6144; ld = 6144; n = ng - mat * 6144; }
    else { base = kv_ada_w; ld = 4096; n = ng - 4 * 6144; }
    float cv[4][4];
#pragma unroll
    for (int b = 0; b < 4; ++b)
#pragma unroll
        for (int j = 0; j < 4; ++j) { const float x = c_in[b * DM + kc * 256 + j * 64 + lane]; cv[b][j] = x / (1.f + __expf(-x)); }
    f32x4 acc[4];
#pragma unroll
    for (int b = 0; b < 4; ++b) acc[b] = (f32x4){0.f, 0.f, 0.f, 0.f};
    const float* wp = base + (size_t)(kc * 256) * ld + n + 4 * lane;
#pragma unroll
    for (int j = 0; j < 4; ++j) {
#pragma unroll 8
        for (int kk = 0; kk < 64; ++kk) {
            const f32x4 w = *(const f32x4*)(wp + (size_t)(j * 64 + kk) * ld);
#pragma unroll
            for (int b = 0; b < 4; ++b) { const float s = __int_as_float(__builtin_amdgcn_readlane(__float_as_int(cv[b][j]), kk)); acc[b] += w * s; }
        }
    }
#pragma unroll
    for (int b = 0; b < 4; ++b) *(f32x4*)(modp + (size_t)(kc * 4 + b) * NTOT + ng + 4 * lane) = acc[b];
}

__device__ __forceinline__ float mod_val(const float* modp, int b, int col, float bias) {
    float s = bias;
#pragma unroll
    for (int kc = 0; kc < KC; ++kc) s += modp[(size_t)(kc * 4 + b) * NTOT + col];
    return s;
}

template <bool HAS_Y, bool XIN16, int XOUT, bool OUT1, bool OUT2>
__device__ __forceinline__ void row_pass(unsigned char* lds, const Args& args, const bf16_t* Y, const void* xin_, void* xout_, int mat_gate, int mat_next, bf16_t* H1, bf16_t* H2) {
    float* gp = (float*)lds; float* ap = gp + DM; float* sp = ap + DM; float* akv = sp + DM; float* skv = akv + DM;
    const float* modp = (const float*)(args.ws + WS_MODP);
    const int tid = threadIdx.x, lane = tid & 63, wave = tid >> 6;
    const int bx = blockIdx.x, b = bx >> 6;
    __syncthreads();
    for (int d = tid; d < DM; d += 512) {
        if (HAS_Y) gp[d] = mod_val(modp, b, mat_gate * 6144 + 4096 + d, args.in[I_ADAB][mat_gate * 6144 + 4096 + d]) * args.in[I_NPOST][mat_gate * DM + d];
        if (OUT1) { ap[d] = (1.f + mod_val(modp, b, mat_next * 6144 + 2048 + d, args.in[I_ADAB][mat_next * 6144 + 2048 + d])) * args.in[I_NPRE][mat_next * DM + d];
                    sp[d] = mod_val(modp, b, mat_next * 6144 + d, args.in[I_ADAB][mat_next * 6144 + d]); }
        if (OUT2) { akv[d] = (1.f + mod_val(modp, b, 4 * 6144 + 2048 + d, args.in[I_KVADAB][2048 + d])) * args.in[I_KVNORM][d];
                    skv[d] = mod_val(modp, b, 4 * 6144 + d, args.in[I_KVADAB][d]); }
    }
    __syncthreads();
#pragma nounroll
    for (int i = 0; i < 8; ++i) {
        const size_t row = (size_t)bx * 64 + wave * 8 + i;
        if (OUT2) asm volatile("" ::: "memory");
        f32x4 xv[8];
        if (XIN16) {
#pragma unroll
            for (int j = 0; j < 8; ++j) { const u32x2 t = *(const u32x2*)((const bf16_t*)xin_ + row * DM + 256 * j + 4 * lane); xv[j] = (f32x4){bf_lo(t.x), bf_hi(t.x), bf_lo(t.y), bf_hi(t.y)}; }
        } else {
#pragma unroll
            for (int j = 0; j < 8; ++j) xv[j] = *(const f32x4*)((const float*)xin_ + row * DM + 256 * j + 4 * lane);
        }
        if (HAS_Y) {
            u32x2 yv[8]; float ss = 0.f;
#pragma unroll
            for (int j = 0; j < 8; ++j) { yv[j] = *(const u32x2*)(Y + row * DM + 256 * j + 4 * lane);
                const float a = bf_lo(yv[j].x), bq = bf_hi(yv[j].x), c = bf_lo(yv[j].y), d = bf_hi(yv[j].y); ss += (a * a + bq * bq) + (c * c + d * d); }
            const float rstd = __builtin_amdgcn_rsqf(wave_sum(ss) * (1.f / DM) + EPS);
#pragma unroll
            for (int j = 0; j < 8; ++j) { const f32x4 g = *(const f32x4*)(gp + 256 * j + 4 * lane);
                const f32x4 y = {bf_lo(yv[j].x), bf_hi(yv[j].x), bf_lo(yv[j].y), bf_hi(yv[j].y)};
                xv[j] = xv[j] + (y * rstd) * g; }
        }
        __builtin_amdgcn_sched_barrier(0);
        if (XOUT == 1) {
#pragma unroll
            for (int j = 0; j < 8; ++j) *(f32x4*)((float*)xout_ + row * DM + 256 * j + 4 * lane) = xv[j];
        }
        if (XOUT == 2) {
#pragma unroll
            for (int j = 0; j < 8; ++j) { u32x2 w; w.x = cvtpk(xv[j][0], xv[j][1]); w.y = cvtpk(xv[j][2], xv[j][3]); *(u32x2*)((bf16_t*)xout_ + row * DM + 256 * j + 4 * lane) = w; }
        }
        if (OUT1 || OUT2) {
            float ss = 0.f;
#pragma unroll
            for (int j = 0; j < 8; ++j) ss += (xv[j][0] * xv[j][0] + xv[j][1] * xv[j][1]) + (xv[j][2] * xv[j][2] + xv[j][3] * xv[j][3]);
            const float rstd = __builtin_amdgcn_rsqf(wave_sum(ss) * (1.f / DM) + EPS);
            __builtin_amdgcn_sched_barrier(0);
            if (OUT1) {
#pragma unroll
                for (int j = 0; j < 8; ++j) { const f32x4 a = *(const f32x4*)(ap + 256 * j + 4 * lane), s = *(const f32x4*)(sp + 256 * j + 4 * lane);
                    const f32x4 h = (xv[j] * rstd) * a + s; u32x2 w; w.x = cvtpk(h[0], h[1]); w.y = cvtpk(h[2], h[3]); *(u32x2*)(H1 + row * DM + 256 * j + 4 * lane) = w; }
            }
            __builtin_amdgcn_sched_barrier(0);
            if (OUT2) {
#pragma unroll
                for (int j = 0; j < 8; ++j) { const f32x4 a = *(const f32x4*)(akv + 256 * j + 4 * lane), s = *(const f32x4*)(skv + 256 * j + 4 * lane);
                    const f32x4 h = (xv[j] * rstd) * a + s; u32x2 w; w.x = cvtpk(h[0], h[1]); w.y = cvtpk(h[2], h[3]); *(u32x2*)(H2 + row * DM + 256 * j + 4 * lane) = w; }
            }
        }
    }
}

__device__ __forceinline__ void conv_pass(const bf16_t* Z, const bf16_t* Bg, const float* cw, bf16_t* Gout) {
    const int gt = blockIdx.x * 512 + threadIdx.x;
    const int ch = (gt & 255) * 8, run = gt >> 8;
    const size_t r0 = (size_t)run * 32; const int s0 = (int)(r0 & (SEQ - 1));
    float w0[8], w1[8], w2[8];
#pragma unroll
    for (int e = 0; e < 8; ++e) { w0[e] = cw[ch + e]; w1[e] = cw[DM + ch + e]; w2[e] = cw[2 * DM + ch + e]; }
    float zm2[8], zm1[8];
    if (s0 == 0) {
#pragma unroll
        for (int e = 0; e < 8; ++e) { zm2[e] = 0.f; zm1[e] = 0.f; }
    } else {
        const u32x4 a = *(const u32x4*)(Z + (r0 - 2) * DM + ch), bq = *(const u32x4*)(Z + (r0 - 1) * DM + ch);
#pragma unroll
        for (int e = 0; e < 4; ++e) { zm2[2 * e] = bf_lo(a[e]); zm2[2 * e + 1] = bf_hi(a[e]); zm1[2 * e] = bf_lo(bq[e]); zm1[2 * e + 1] = bf_hi(bq[e]); }
    }
#pragma unroll 4
    for (int i = 0; i < 32; ++i) {
        const u32x4 zz = *(const u32x4*)(Z + (r0 + i) * DM + ch), bb = *(const u32x4*)(Bg + (r0 + i) * DM + ch);
        float z[8], o[8];
#pragma unroll
        for (int e = 0; e < 4; ++e) { z[2 * e] = bf_lo(zz[e]); z[2 * e + 1] = bf_hi(zz[e]); }
#pragma unroll
        for (int e = 0; e < 4; ++e) { o[2 * e] = bf_lo(bb[e]) * (w0[2 * e] * zm2[2 * e] + w1[2 * e] * zm1[2 * e] + w2[2 * e] * z[2 * e]);
                                      o[2 * e + 1] = bf_hi(bb[e]) * (w0[2 * e + 1] * zm2[2 * e + 1] + w1[2 * e + 1] * zm1[2 * e + 1] + w2[2 * e + 1] * z[2 * e + 1]); }
        u32x4 w; w.x = cvtpk(o[0], o[1]); w.y = cvtpk(o[2], o[3]); w.z = cvtpk(o[4], o[5]); w.w = cvtpk(o[6], o[7]);
        *(u32x4*)(Gout + (r0 + i) * DM + ch) = w;
#pragma unroll
        for (int e = 0; e < 8; ++e) { zm2[e] = zm1[e]; zm1[e] = z[e]; }
    }
}

constexpr int KROW = 144, VROW = 528;
constexpr int ALDS_K = 0, ALDS_V = 256 * KROW;
__device__ __forceinline__ int crow(int r, int hi) { return (r & 3) + 8 * (r >> 2) + 4 * hi; }
__device__ __forceinline__ void attn_phase(unsigned char* lds, const bf16_t* Q, const bf16_t* Kg, const bf16_t* Vtg, bf16_t* O, const float* sinks) {
    const int tid = threadIdx.x, lane = tid & 63, wave = tid >> 6, r = lane & 31, hi = lane >> 5;
    for (int unit = blockIdx.x; unit < NBATCH * 32 * NKV; unit += gridDim.x) {
        const int b = unit >> 7, nb = (unit >> 2) & 31, kvh = unit & 3;
        __syncthreads();
#pragma unroll
        for (int i = 0; i < 4; ++i) { const int id = tid + 512 * i, row = id >> 3, ch = id & 7, pos = (nb - 1) * 128 + row;
            u32x4 v = {0u, 0u, 0u, 0u}; if (pos >= 0) v = *(const u32x4*)(Kg + (size_t)(b * SEQ + pos) * 256 + kvh * 64 + ch * 8);
            *(u32x4*)(lds + ALDS_K + row * KROW + ch * 16) = v; }
#pragma unroll
        for (int i = 0; i < 4; ++i) { const int id = tid + 512 * i, d = id >> 5, ch = id & 31, key0 = (nb - 1) * 128 + ch * 8;
            u32x4 v = {0u, 0u, 0u, 0u}; if (key0 >= 0) v = *(const u32x4*)(Vtg + ((size_t)(b * NKV + kvh) * HD + d) * SEQ + key0);
            *(u32x4*)(lds + ALDS_V + d * VROW + ch * 16) = v; }
        __syncthreads();
        const int head = kvh * 8 + wave;
        const float sink = sinks[head] * LOG2E;
        for (int qg = 0; qg < 4; ++qg) {
            const size_t row = (size_t)b * SEQ + nb * 128 + qg * 32 + r;
            bf16x8 qf[4];
#pragma unroll
            for (int s = 0; s < 4; ++s) qf[s] = *(const bf16x8*)(Q + row * DM + head * 64 + 16 * s + 8 * hi);
            f32x16 st[5];
#pragma unroll
            for (int kt = 0; kt < 5; ++kt) {
                f32x16 a;
#pragma unroll
                for (int e = 0; e < 16; ++e) a[e] = 0.f;
#pragma unroll
                for (int s = 0; s < 4; ++s) { const bf16x8 kf = *(const bf16x8*)(lds + ALDS_K + (32 * (qg + kt) + r) * KROW + (16 * s + 8 * hi) * 2);
                    a = __builtin_amdgcn_mfma_f32_32x32x16_bf16(kf, qf[s], a, 0, 0, 0); }
                st[kt] = a;
            }
            float mx = sink;
#pragma unroll
            for (int kt = 0; kt < 5; ++kt)
#pragma unroll
                for (int e = 0; e < 16; ++e) {
                    const int diff = 32 * kt + crow(e, hi) - r;
                    bool valid = true;
                    if (kt == 0) valid = diff >= 1;
                    if (kt == 4) valid = diff <= 128;
                    if (nb == 0 && (qg + kt) < 4) valid = false;
                    const float s = valid ? st[kt][e] : -INFINITY;
                    st[kt][e] = s; mx = fmaxf(mx, s);
                }
            mx = fmaxf(mx, __shfl_xor(mx, 32));
            float l = 0.f;
#pragma unroll
            for (int kt = 0; kt < 5; ++kt)
#pragma unroll
                for (int e = 0; e < 16; ++e) { const float p = __builtin_amdgcn_exp2f(st[kt][e] - mx); st[kt][e] = p; l += p; }
            l += __shfl_xor(l, 32);
            l += __builtin_amdgcn_exp2f(sink - mx);
            f32x16 o0, o1;
#pragma unroll
            for (int e = 0; e < 16; ++e) { o0[e] = 0.f; o1[e] = 0.f; }
#pragma unroll
            for (int kt = 0; kt < 5; ++kt)
#pragma unroll
                for (int s2 = 0; s2 < 2; ++s2) {
                    u32x4 pw; pw.x = cvtpk(st[kt][8 * s2 + 0], st[kt][8 * s2 + 1]); pw.y = cvtpk(st[kt][8 * s2 + 2], st[kt][8 * s2 + 3]);
                    pw.z = cvtpk(st[kt][8 * s2 + 4], st[kt][8 * s2 + 5]); pw.w = cvtpk(st[kt][8 * s2 + 6], st[kt][8 * s2 + 7]);
                    const bf16x8 pf = __builtin_bit_cast(bf16x8, pw);
                    const int kb = 32 * (qg + kt) + 16 * s2 + 4 * hi;
                    const s16x4 lo0 = *(const s16x4*)(lds + ALDS_V + r * VROW + kb * 2), hi0 = *(const s16x4*)(lds + ALDS_V + r * VROW + (kb + 8) * 2);
                    const s16x4 lo1 = *(const s16x4*)(lds + ALDS_V + (32 + r) * VROW + kb * 2), hi1 = *(const s16x4*)(lds + ALDS_V + (32 + r) * VROW + (kb + 8) * 2);
                    const bf16x8 v0 = __builtin_shufflevector(lo0, hi0, 0, 1, 2, 3, 4, 5, 6, 7), v1 = __builtin_shufflevector(lo1, hi1, 0, 1, 2, 3, 4, 5, 6, 7);
                    o0 = __builtin_amdgcn_mfma_f32_32x32x16_bf16(v0, pf, o0, 0, 0, 0);
                    o1 = __builtin_amdgcn_mfma_f32_32x32x16_bf16(v1, pf, o1, 0, 0, 0);
                }
            const float il = 1.f / l;
            bf16_t* op = O + row * DM + head * 64 + 4 * hi;
#pragma unroll
            for (int ig = 0; ig < 4; ++ig) {
                u32x2 w0, w1;
                w0.x = cvtpk(o0[4 * ig] * il, o0[4 * ig + 1] * il); w0.y = cvtpk(o0[4 * ig + 2] * il, o0[4 * ig + 3] * il);
                w1.x = cvtpk(o1[4 * ig] * il, o1[4 * ig + 1] * il); w1.y = cvtpk(o1[4 * ig + 2] * il, o1[4 * ig + 3] * il);
                *(u32x2*)(op + 8 * ig) = w0; *(u32x2*)(op + 32 + 8 * ig) = w1;
            }
        }
    }
}

__device__ __forceinline__ float rope_inv(int i) {
    return i == 0 ? 1.0f : i == 1 ? 0.1939227432012558f : i == 2 ? 0.03760603070259094f : i == 3 ? 0.007292664609849453f :
           i == 4 ? 0.0014142135623842478f : i == 5 ? 0.00027424818836152554f : i == 6 ? 5.3182957344688475e-05f : 1.0313385246263351e-05f;
}

__device__ __forceinline__ void prologue(unsigned char* lds, const Args& args) {
    const int tid = threadIdx.x, lane = tid & 63, wave = tid >> 6;
    const int G = gridDim.x, bx = blockIdx.x;
    const int vcu = (G % 8 == 0) ? (bx % 8) * (G / 8) + bx / 8 : bx;
    const int gw = vcu * NWAVES + wave, NGW = G * NWAVES;
    unsigned char* ws = args.ws;
    { const int id = bx * 512 + tid;
      if (id < SEQ * 8) { const int pos = id >> 3, i = id & 7; const float ang = (float)pos * rope_inv(i);
          const double rev = (double)ang * 0.15915494309189535; const float fr = (float)(rev - floor(rev));
          float* rp = (float*)(ws + WS_ROPE) + pos * 16; rp[i] = __builtin_amdgcn_cosf(fr); rp[8 + i] = __builtin_amdgcn_sinf(fr); } }
    for (int it = gw; it < (NTOT / 256) * KC; it += NGW) gemv_item(args.in[I_C], args.in[I_ADAW], args.in[I_KVADAW], (float*)(ws + WS_MODP), it, lane);
    LAS float* scr = (LAS float*)((LAS unsigned char*)lds + wave * 16384);
    constexpr int I_IN = 32 * 192, I_OUT = 32 * 64, I_UPI = 32 * 256, I_DN = 128 * 64, I_Q = 32 * 64, I_KV = 32 * 16, I_O = 32 * 64;
    constexpr int NITEMS = I_IN + I_OUT + 2 * I_UPI + 2 * I_DN + I_Q + I_KV + I_O;
    for (int it = gw; it < NITEMS; it += NGW) {
        int q = it;
        if (q < I_IN) { transpose_item(args.in[I_CWIN], DM, 3 * DM, (bf16_t*)(ws + WS_WIN), q, 1, scr, lane); continue; } q -= I_IN;
        if (q < I_OUT) { transpose_item(args.in[I_CWOUT], DM, DM, (bf16_t*)(ws + WS_WOUT), q, 0, scr, lane); continue; } q -= I_OUT;
        if (q < I_UPI) { transpose_item(args.in[I_UP], DM, DFF, (bf16_t*)(ws + WS_WUP0), q, 0, scr, lane); continue; } q -= I_UPI;
        if (q < I_UPI) { transpose_item(args.in[I_UP] + (size_t)DM * DFF, DM, DFF, (bf16_t*)(ws + WS_WUP1), q, 0, scr, lane); continue; } q -= I_UPI;
        if (q < I_DN) { transpose_item(args.in[I_DOWN], DFF, DM, (bf16_t*)(ws + WS_WDN0), q, 0, scr, lane); continue; } q -= I_DN;
        if (q < I_DN) { transpose_item(args.in[I_DOWN] + (size_t)DM * DFF, DFF, DM, (bf16_t*)(ws + WS_WDN1), q, 0, scr, lane); continue; } q -= I_DN;
        if (q < I_Q) { transpose_item(args.in[I_WQ], DM, DM, (bf16_t*)(ws + WS_WQ), q, 0, scr, lane); continue; } q -= I_Q;
        if (q < I_KV) { transpose_item(args.in[I_WKV], DM, 512, (bf16_t*)(ws + WS_WKV), q, 0, scr, lane); continue; } q -= I_KV;
        transpose_item(args.in[I_WO], DM, DM, (bf16_t*)(ws + WS_WO), q, 0, scr, lane);
    }
}

constexpr int N_PHASES = 16;
__global__ void __launch_bounds__(NWAVES * 64, 2) yoco_fwd(Args args) {
    extern __shared__ __attribute__((aligned(16))) unsigned char lds[];
#define G ((int)gridDim.x)
    const int lo = args.ph_lo, hi = args.ph_hi;
#define ldsg ((LAS unsigned char*)lds)
#if MK_XCD_BAR
    volatile LAS unsigned* misc = (volatile LAS unsigned*)(ldsg + 131072);
    if (threadIdx.x < 2) misc[threadIdx.x] = 0u;
    __syncthreads();
    (void)xcd_barrier_post((unsigned*)(args.ws + WS_CTL) + 1024, misc);
#define GRID_BAR(k) do { if ((k) == 0) cg::this_grid().sync(); else { XcdBarrier bar_; bar_.bar = (unsigned*)(args.ws + WS_CTL) + 1024; bar_.x = xb_xcc_id(); bar_.st = (volatile LAS unsigned*)((LAS unsigned char*)lds + 131072); xcd_barrier(bar_); } } while (0)
#else
#define GRID_BAR(k) cg::this_grid().sync()
#endif
#define IN(k) (lo <= (k) && (k) < hi)
#define SEAM(k) do { if (IN(k) && IN((k) + 1)) GRID_BAR(k); } while (0)
#define H ((bf16_t*)(args.ws + WS_H))
#define ZQ ((bf16_t*)(args.ws + WS_ZQ))
#define BO ((bf16_t*)(args.ws + WS_BO))
#define GK ((bf16_t*)(args.ws + WS_GK))
#define A ((bf16_t*)(args.ws + WS_A))
#define Kb ((bf16_t*)(args.ws + WS_K))
#define Vt ((bf16_t*)(args.ws + WS_VT))
#define rope ((const float*)(args.ws + WS_ROPE))
    pg8::StaticOrder S;

    if (IN(0)) { prologue(lds, args); } SEAM(0);
    if (IN(1)) { row_pass<false, false, 0, true, false>(lds, args, nullptr, args.in[I_X], nullptr, 0, 0, H, nullptr); } SEAM(1);
    if (IN(2)) { pg8::Gemm g{H, (const bf16_t*)(args.ws + WS_WIN), T, 3 * DM, DM}; S.init(T, 3 * DM, G, (int)blockIdx.x); pg8::EpiZB E{ZQ, BO};
        pg8::gemm_phase<pg8::EpiZB, pg8::StaticOrder, PG8_ALIGN, PG8_SP2>(ldsg, g, S, E); } SEAM(2);
    if (IN(3)) { conv_pass(ZQ, BO, args.in[I_CONVW], GK); } SEAM(3);
    if (IN(4)) { pg8::Gemm g{GK, (const bf16_t*)(args.ws + WS_WOUT), T, DM, DM}; S.init(T, DM, G, (int)blockIdx.x); pg8::EpiBf16<0> E{H, DM, nullptr};
        pg8::gemm_phase<pg8::EpiBf16<0>, pg8::StaticOrder, PG8_ALIGN, PG8_SP2>(ldsg, g, S, E); } SEAM(4);
    if (IN(5)) { row_pass<true, false, 2, true, false>(lds, args, H, args.in[I_X], args.out, 0, 1, H, nullptr); } SEAM(5);
    if (IN(6)) { pg8::Gemm g{H, (const bf16_t*)(args.ws + WS_WUP0), T, DFF, DM}; S.init(T, DFF, G, (int)blockIdx.x); pg8::EpiBf16<1> E{A, DFF, nullptr};
        pg8::gemm_phase<pg8::EpiBf16<1>, pg8::StaticOrder, PG8_ALIGN, PG8_SP2>(ldsg, g, S, E); } SEAM(6);
    if (IN(7)) { pg8::Gemm g{A, (const bf16_t*)(args.ws + WS_WDN0), T, DM, DFF}; S.init(T, DM, G, (int)blockIdx.x); pg8::EpiBf16<0> E{H, DM, nullptr};
        pg8::gemm_phase<pg8::EpiBf16<0>, pg8::StaticOrder, PG8_ALIGN, PG8_SP2>(ldsg, g, S, E); } SEAM(7);
    if (IN(8)) { row_pass<true, true, 2, true, true>(lds, args, H, args.out, args.out, 1, 2, H, GK); } SEAM(8);
    if (IN(9)) {
        { pg8::Gemm g{H, (const bf16_t*)(args.ws + WS_WQ), T, DM, DM}; S.init(T, DM, G, (int)blockIdx.x); pg8::EpiQ E{ZQ, args.in[I_BQ], rope};
          pg8::gemm_phase<pg8::EpiQ, pg8::StaticOrder, PG8_ALIGN, PG8_SP2>(ldsg, g, S, E); }
        { pg8::Gemm g{GK, (const bf16_t*)(args.ws + WS_WKV), T, 512, DM}; S.init(T, 512, G, (int)blockIdx.x); pg8::EpiKV E{Kb, Vt, args.in[I_BKV], rope};
          pg8::gemm_phase<pg8::EpiKV, pg8::StaticOrder, PG8_ALIGN, PG8_SP2>(ldsg, g, S, E); }
    } SEAM(9);
    if (IN(10)) { attn_phase(lds, ZQ, Kb, Vt, BO, args.in[I_SINKS]); } SEAM(10);
    if (IN(11)) { pg8::Gemm g{BO, (const bf16_t*)(args.ws + WS_WO), T, DM, DM}; S.init(T, DM, G, (int)blockIdx.x); pg8::EpiBf16<0> E{H, DM, args.in[I_BO]};
        pg8::gemm_phase<pg8::EpiBf16<0>, pg8::StaticOrder, PG8_ALIGN, PG8_SP2>(ldsg, g, S, E); } SEAM(11);
    if (IN(12)) { row_pass<true, true, 2, true, false>(lds, args, H, args.out, ZQ, 2, 3, H, nullptr); } SEAM(12);
    if (IN(13)) { pg8::Gemm g{H, (const bf16_t*)(args.ws + WS_WUP1), T, DFF, DM}; S.init(T, DFF, G, (int)blockIdx.x); pg8::EpiBf16<1> E{A, DFF, nullptr};
        pg8::gemm_phase<pg8::EpiBf16<1>, pg8::StaticOrder, PG8_ALIGN, PG8_SP2>(ldsg, g, S, E); } SEAM(13);
    if (IN(14)) { pg8::Gemm g{A, (const bf16_t*)(args.ws + WS_WDN1), T, DM, DFF}; S.init(T, DM, G, (int)blockIdx.x); pg8::EpiBf16<0> E{H, DM, nullptr};
        pg8::gemm_phase<pg8::EpiBf16<0>, pg8::StaticOrder, PG8_ALIGN, PG8_SP2>(ldsg, g, S, E); } SEAM(14);
    if (IN(15)) { row_pass<true, true, 1, false, false>(lds, args, H, ZQ, args.out, 3, 0, nullptr, nullptr); }
#undef IN
#undef SEAM
#undef H
#undef ZQ
#undef BO
#undef GK
#undef A
#undef Kb
#undef Vt
#undef rope
#undef G
#undef ldsg
}

extern "C" void kernel_launch(void* const* d_in, const int* in_sizes, int n_in, void* d_out, int out_size, void* d_ws, size_t ws_size, hipStream_t stream) {
    static int grid = 0;
    if (grid == 0) {
        if (n_in != 21 || in_sizes[0] != T * DM || out_size != T * DM || ws_size < WS_END) { fprintf(stderr, "kernel_launch: unexpected shapes (n_in %d, in0 %d, out %d, ws %zu); nothing launched\n", n_in, n_in > 0 ? in_sizes[0] : -1, out_size, ws_size); grid = -1; return; }
        int dev = 0, cus = 0, per_cu = 0;
        if (hipGetDevice(&dev) != hipSuccess || hipDeviceGetAttribute(&cus, hipDeviceAttributeMultiprocessorCount, dev) != hipSuccess) { grid = -1; return; }
        if (hipFuncSetAttribute((const void*)yoco_fwd, hipFuncAttributeMaxDynamicSharedMemorySize, LDS_BYTES) != hipSuccess) { fprintf(stderr, "kernel_launch: hipFuncSetAttribute failed\n"); grid = -1; return; }
        if (hipOccupancyMaxActiveBlocksPerMultiprocessor(&per_cu, (const void*)yoco_fwd, NWAVES * 64, LDS_BYTES) != hipSuccess || per_cu < 1) { fprintf(stderr, "kernel_launch: occupancy query says %d\n", per_cu); per_cu = 1; }
        (void)hipGetLastError();
        grid = cus * 1;
        if (grid != 256) { fprintf(stderr, "kernel_launch: built for a 256-CU device, found %d CUs\n", cus); grid = -1; return; }
    }
    if (grid < 0) return;
    Args a{};
    for (int i = 0; i < 21; ++i) a.in[i] = (const float*)d_in[i];
    a.out = (float*)d_out; a.ws = (unsigned char*)d_ws;
    if (MK_N_LAUNCHES == 1) {
        (void)hipMemsetAsync((char*)d_ws + WS_CTL, 0, CTL_ZERO_BYTES, stream);
        a.ph_lo = 0; a.ph_hi = N_PHASES;
        void* kargs[] = {&a};
        hipError_t e = hipLaunchCooperativeKernel((const void*)yoco_fwd, dim3(grid), dim3(NWAVES * 64), kargs, LDS_BYTES, stream);
        if (e != hipSuccess) fprintf(stderr, "kernel_launch: cooperative launch failed: %s\n", hipGetErrorString(e));
    } else {
        for (int p = 0; p < N_PHASES; ++p) for (int rep = 0; rep <= ((PROBE_MASK >> p) & 1); ++rep) { a.ph_lo = p; a.ph_hi = p + 1; hipLaunchKernelGGL(yoco_fwd, dim3(grid), dim3(NWAVES * 64), LDS_BYTES, stream, a); }
    }
}
```
